# Optimizing an MI355X kernel written in HIP

```python
import jax, jax.numpy as jnp
from jax import lax
import numpy as np

D_MODEL = 1024
BATCH = 2
SEQ = 8192
DEPTH = 2
DEC_BATCH = 32
DEC_SEQ = 16
PAST_LEN = 1024

CHUNK = 64
LEFT_CHUNKS = 8
ATTN_REACH = LEFT_CHUNKS * CHUNK
N_HEADS_A = 8
HEAD_DIM_A = 64
D_A = N_HEADS_A * HEAD_DIM_A
REL_CLIP = 128
N_REL = 2 * REL_CLIP + 1
MLP_CHUNK = 128
N_GROUPS_B = 4
D_B = 512
GROUP_DIM_B = D_B // N_GROUPS_B
D_FF = ((8 * D_MODEL // 3 + 255) // 256) * 256
CONV_W = 3
N_BRANCH = 2
D_IN = 3 * D_A + 2 * D_B + N_BRANCH * D_MODEL
EPS = 1e-6

kernel_name = 'streaming_band_attn_spatial_gating_convffn'


def rms_norm(x, g):
    xf = x.astype(jnp.float32)
    y = xf * lax.rsqrt(jnp.mean(xf * xf, axis=-1, keepdims=True) + EPS)
    return (y * g.astype(jnp.float32)).astype(x.dtype)


def ada_params(c, w_ada, b_ada):
    mod = jax.nn.silu(c) @ w_ada + b_ada
    return jnp.split(mod[:, None, :], 6, axis=-1)


def modulate(h, shift, scale):
    return h * (1 + scale) + shift


def mixer_inputs(h, w_in, q_norm_g, k_norm_g, v_norm_g):
    B, T, _ = h.shape
    z = h @ w_in
    q, k, v, zb, gates = jnp.split(z, [D_A, 2 * D_A, 3 * D_A, 3 * D_A + 2 * D_B], axis=-1)
    q = rms_norm(q.reshape(B, T, N_HEADS_A, HEAD_DIM_A), q_norm_g)
    k = rms_norm(k.reshape(B, T, N_HEADS_A, HEAD_DIM_A), k_norm_g)
    v = v.reshape(B, T, N_HEADS_A, HEAD_DIM_A)
    ub, vb = jnp.split(jax.nn.gelu(zb), 2, axis=-1)
    vb = rms_norm(vb, v_norm_g).reshape(B, T, N_GROUPS_B, GROUP_DIM_B)
    g_a, g_b = jnp.split(jax.nn.sigmoid(gates), 2, axis=-1)
    return q, k, v, ub, vb, g_a, g_b


def band_attention_prompt(q, k, v, rel_bias):
    B, S, H, dh = q.shape
    nC = S // CHUNK
    band = (LEFT_CHUNKS + 1) * CHUNK
    qc = q.reshape(B, nC, CHUNK, H, dh)
    pad = jnp.zeros((B, ATTN_REACH, H, dh), k.dtype)
    kp = jnp.concatenate([pad, k], axis=1).reshape(B, nC + LEFT_CHUNKS, CHUNK, H, dh)
    vp = jnp.concatenate([pad.astype(v.dtype), v], axis=1).reshape(B, nC + LEFT_CHUNKS, CHUNK, H, dh)
    kb = jnp.concatenate([kp[:, j:j + nC] for j in range(LEFT_CHUNKS + 1)], axis=2)
    vb = jnp.concatenate([vp[:, j:j + nC] for j in range(LEFT_CHUNKS + 1)], axis=2)
    s = jnp.einsum('bcqhd,bckhd->bchqk', qc, kb, preferred_element_type=jnp.float32) * (dh ** -0.5)
    i = jnp.arange(CHUNK)[:, None]
    kk = jnp.arange(band)[None, :]
    idx = jnp.clip(ATTN_REACH + i - kk, -REL_CLIP, REL_CLIP) + REL_CLIP
    s = s + rel_bias.astype(jnp.float32)[:, idx][None, None]
    key_chunk = jnp.arange(nC)[:, None] - LEFT_CHUNKS + jnp.arange(LEFT_CHUNKS + 1)[None, :]
    valid = jnp.repeat(key_chunk >= 0, CHUNK, axis=1)
    s = jnp.where(valid[None, :, None, None, :], s, -jnp.inf)
    p = jax.nn.softmax(s, axis=-1)
    o = jnp.einsum('bchqk,bckhd->bcqhd', p.astype(v.dtype), vb)
    return o.reshape(B, S, H * dh)


def band_attention_sample(q, k, v, k_cache, v_cache, rel_bias):
    B, T, H, dh = q.shape
    L = k_cache.shape[1]
    kk_all = jnp.concatenate([k_cache.astype(k.dtype), k], axis=1)
    vv_all = jnp.concatenate([v_cache.astype(v.dtype), v], axis=1)
    s = jnp.einsum('bqhd,bkhd->bhqk', q, kk_all, preferred_element_type=jnp.float32) * (dh ** -0.5)
    i = jnp.arange(T)[:, None]
    kk = jnp.arange(L + T)[None, :]
    idx = jnp.clip(L + i - kk, -REL_CLIP, REL_CLIP) + REL_CLIP
    s = s + rel_bias.astype(jnp.float32)[:, idx][None]
    p = jax.nn.softmax(s, axis=-1)
    o = jnp.einsum('bhqk,bkhd->bqhd', p.astype(v.dtype), vv_all)
    return o.reshape(B, T, H * dh)


def causal_spatial(w_spatial):
    return w_spatial * jnp.tril(jnp.ones((MLP_CHUNK, MLP_CHUNK), w_spatial.dtype))


def spatial_gating_prompt(ub, vb, w_spatial, b_spatial):
    B, S, _ = ub.shape
    vc = vb.reshape(B, S // MLP_CHUNK, MLP_CHUNK, N_GROUPS_B, GROUP_DIM_B)
    mix = jnp.einsum('gts,bcsgd->bctgd', causal_spatial(w_spatial), vc)
    mix = mix + b_spatial.T[None, None, :, :, None]
    return ub * mix.reshape(B, S, D_B)


def spatial_gating_sample(ub, vb, w_spatial, b_spatial):
    B, T, _ = ub.shape
    ws = causal_spatial(w_spatial)[:, :T, :T]
    mix = jnp.einsum('gts,bsgd->btgd', ws, vb) + b_spatial[:, :T].T[None, :, :, None]
    return ub * mix.reshape(B, T, D_B)


def conv_ffn(h, conv_cache, w_ffn_in, ffn_conv_w, ffn_conv_b, w_ffn_out):
    B, T, _ = h.shape
    g, u = jnp.split(h @ w_ffn_in, 2, axis=-1)
    if conv_cache is None:
        conv_cache = jnp.zeros((B, CONV_W - 1, D_FF), g.dtype)
    gp = jnp.concatenate([conv_cache.astype(g.dtype), g], axis=1)
    gc = ffn_conv_b
    for j in range(CONV_W):
        gc = gc + ffn_conv_w[j] * gp[:, j:j + T]
    out = (jax.nn.gelu(gc) * u) @ w_ffn_out
    return out, gp[:, -(CONV_W - 1):]


def run_layer(x, c, k_cache, v_cache, conv_cache, norm1_g, norm2_g, w_ada, b_ada, w_in,
              q_norm_g, k_norm_g, rel_bias, v_norm_g, w_spatial, b_spatial,
              w_out_a, w_out_b, w_out, w_ffn_in, ffn_conv_w, ffn_conv_b, w_ffn_out):
    sh1, sc1, gt1, sh2, sc2, gt2 = ada_params(c, w_ada, b_ada)
    h = modulate(rms_norm(x, norm1_g), sh1, sc1)
    q, k, v, ub, vb, g_a, g_b = mixer_inputs(h, w_in, q_norm_g, k_norm_g, v_norm_g)
    if k_cache is None:
        o_a = band_attention_prompt(q, k, v, rel_bias)
        o_b = spatial_gating_prompt(ub, vb, w_spatial, b_spatial)
        keep = min(ATTN_REACH, x.shape[1])
        k_state, v_state, vb_state = k[:, -keep:], v[:, -keep:], None
    else:
        o_a = band_attention_sample(q, k, v, k_cache, v_cache, rel_bias)
        o_b = spatial_gating_sample(ub, vb, w_spatial, b_spatial)
        k_state, v_state, vb_state = k, v, vb
    mixed = (g_a * (o_a @ w_out_a) + g_b * (o_b @ w_out_b)) @ w_out
    x = x + gt1 * mixed
    h2 = modulate(rms_norm(x, norm2_g), sh2, sc2)
    f, conv_state = conv_ffn(h2, conv_cache, w_ffn_in, ffn_conv_w, ffn_conv_b, w_ffn_out)
    x = x + gt2 * f
    return x, k_state, v_state, vb_state, conv_state


def setup_inputs(seed: int = 0) -> dict:
    key = jax.random.key(seed)
    ks = jax.random.split(key, 32)
    f32 = jnp.float32

    def nrm(k, shape, scale):
        return jax.random.normal(k, shape, f32) * scale

    cache_len = min(ATTN_REACH, PAST_LEN)
    return {
        'x_prompt': nrm(ks[0], (BATCH, SEQ, D_MODEL), 1.0),
        'x_sample': nrm(ks[1], (DEC_BATCH, DEC_SEQ, D_MODEL), 1.0),
        'cache_attn_k': nrm(ks[2], (DEPTH, DEC_BATCH, cache_len, N_HEADS_A, HEAD_DIM_A), 1.0),
        'cache_attn_v': nrm(ks[3], (DEPTH, DEC_BATCH, cache_len, N_HEADS_A, HEAD_DIM_A), 1.0),
        'cache_ffn_conv': nrm(ks[4], (DEPTH, DEC_BATCH, CONV_W - 1, D_FF), 1.0),
        'c_prompt': nrm(ks[5], (BATCH, D_MODEL), 1.0),
        'c_sample': nrm(ks[6], (DEC_BATCH, D_MODEL), 1.0),
        'norm1_g': 1.0 + nrm(ks[7], (DEPTH, D_MODEL), 0.02),
        'norm2_g': 1.0 + nrm(ks[8], (DEPTH, D_MODEL), 0.02),
        'w_ada': nrm(ks[9], (DEPTH, D_MODEL, 6 * D_MODEL), 0.5 * D_MODEL ** -0.5),
        'b_ada': nrm(ks[10], (DEPTH, 6 * D_MODEL), 0.02),
        'w_in': nrm(ks[11], (DEPTH, D_MODEL, D_IN), D_MODEL ** -0.5),
        'q_norm_g': 1.0 + nrm(ks[12], (DEPTH, HEAD_DIM_A), 0.02),
        'k_norm_g': 1.0 + nrm(ks[13], (DEPTH, HEAD_DIM_A), 0.02),
        'rel_bias': nrm(ks[14], (DEPTH, N_HEADS_A, N_REL), 0.1),
        'v_norm_g': 1.0 + nrm(ks[15], (DEPTH, D_B), 0.02),
        'w_spatial': nrm(ks[16], (DEPTH, N_GROUPS_B, MLP_CHUNK, MLP_CHUNK), MLP_CHUNK ** -0.5),
        'b_spatial': 1.0 + nrm(ks[17], (DEPTH, N_GROUPS_B, MLP_CHUNK), 0.02),
        'w_out_a': nrm(ks[18], (DEPTH, D_A, D_MODEL), D_A ** -0.5),
        'w_out_b': nrm(ks[19], (DEPTH, D_B, D_MODEL), D_B ** -0.5),
        'w_out': nrm(ks[20], (DEPTH, D_MODEL, D_MODEL), D_MODEL ** -0.5),
        'w_ffn_in': nrm(ks[21], (DEPTH, D_MODEL, 2 * D_FF), D_MODEL ** -0.5),
        'ffn_conv_w': nrm(ks[22], (DEPTH, CONV_W, D_FF), CONV_W ** -0.5),
        'ffn_conv_b': nrm(ks[23], (DEPTH, D_FF), 0.02),
        'w_ffn_out': nrm(ks[24], (DEPTH, D_FF, D_MODEL), D_FF ** -0.5),
    }


def reference(x_prompt, x_sample, cache_attn_k, cache_attn_v, cache_ffn_conv, c_prompt, c_sample,
              norm1_g, norm2_g, w_ada, b_ada, w_in, q_norm_g, k_norm_g, rel_bias, v_norm_g,
              w_spatial, b_spatial, w_out_a, w_out_b, w_out, w_ffn_in, ffn_conv_w, ffn_conv_b,
              w_ffn_out):
    xp, xs = x_prompt, x_sample
    kp_l, vp_l, cp_l, ks_l, vs_l, bs_l, cs_l = [], [], [], [], [], [], []
    for l in range(DEPTH):
        lw = (norm1_g[l], norm2_g[l], w_ada[l], b_ada[l], w_in[l], q_norm_g[l], k_norm_g[l],
              rel_bias[l], v_norm_g[l], w_spatial[l], b_spatial[l], w_out_a[l], w_out_b[l],
              w_out[l], w_ffn_in[l], ffn_conv_w[l], ffn_conv_b[l], w_ffn_out[l])
        xp, kp, vp, _, cp = run_layer(xp, c_prompt, None, None, None, *lw)
        xs, ks, vs, bs, cs = run_layer(xs, c_sample, cache_attn_k[l], cache_attn_v[l],
                                       cache_ffn_conv[l], *lw)
        kp_l.append(kp); vp_l.append(vp); cp_l.append(cp)
        ks_l.append(ks); vs_l.append(vs); bs_l.append(bs); cs_l.append(cs)
    new_k_prompt = jnp.stack(kp_l)
    new_v_prompt = jnp.stack(vp_l)
    new_conv_prompt = jnp.stack(cp_l)
    new_k_sample = jnp.stack(ks_l)
    new_v_sample = jnp.stack(vs_l)
    new_spatial_v_sample = jnp.stack(bs_l)
    new_conv_sample = jnp.stack(cs_l)
    return (xp, xs, new_k_prompt, new_v_prompt, new_conv_prompt, new_k_sample, new_v_sample, new_spatial_v_sample, new_conv_sample)
```

```cpp
#define MK_PER_PHASE 1
#include <hip/hip_runtime.h>
#include <cstdio>
#include <cstdint>

constexpr int DM = 1024, NBATCH = 2, SEQ = 8192, DEPTH = 2, DECB = 32, DECT = 16;
constexpr int MP = NBATCH * SEQ, MS = DECB * DECT, MT = MP + MS;
constexpr int NH = 8, HD = 64, DA = 512, DB = 512, NG = 4, GD = 128, DFF = 2816, DIN = 4608, NREL = 257;
constexpr int NMODB = NBATCH + DECB;
constexpr float EPS = 1e-6f;
constexpr float LOG2E = 1.4426950408889634f;
constexpr float QSCALE = 0.125f * LOG2E;
constexpr size_t O_Y = 0, O_KP = (size_t)MT * DM, O_VP = O_KP + (size_t)DEPTH * NBATCH * 512 * 512, O_CP = O_VP + (size_t)DEPTH * NBATCH * 512 * 512,
                 O_KS = O_CP + (size_t)DEPTH * NBATCH * 2 * DFF, O_VS = O_KS + (size_t)DEPTH * DECB * DECT * 512, O_BS = O_VS + (size_t)DEPTH * DECB * DECT * 512,
                 O_CS = O_BS + (size_t)DEPTH * DECB * DECT * 512, O_END = O_CS + (size_t)DEPTH * DECB * 2 * DFF;
static_assert(O_END == 21354496, "output size");

constexpr size_t MiB = 1u << 20;
constexpr size_t WS_CTL = 0, CTL_ZERO_BYTES = 64 * 1024;
constexpr size_t WS_MOD = 1 * MiB;
constexpr size_t WS_VSS = 3 * MiB;
constexpr size_t WS_W = 4 * MiB;
constexpr size_t W_IN = 0, W_AB = (size_t)DIN * DM * 2, W_O = W_AB + (size_t)DM * DM * 2, W_F1 = W_O + (size_t)DM * DM * 2, W_F2 = W_F1 + (size_t)2 * DFF * DM * 2,
                 W_LAYER = W_F2 + (size_t)DM * DFF * 2;
constexpr size_t WS_H = 68 * MiB;
constexpr size_t WS_ACT = 102 * MiB;
constexpr size_t A_Q = 0, A_K = A_Q + (size_t)MT * 512 * 2, A_V = A_K + (size_t)MT * 512 * 2, A_UB = A_V + (size_t)MT * 512 * 2, A_VB = A_UB + (size_t)MT * 512 * 2,
                 A_GR = A_VB + (size_t)MT * 512 * 2, A_GB = A_GR + (size_t)MT * DM * 2, A_OAB = A_GB + (size_t)MT * DM * 2, A_MIX = A_OAB + (size_t)MT * DM * 2,
                 A_END = A_MIX + (size_t)MT * DM * 2;
constexpr size_t A_G = 0, A_U = (size_t)MT * DFF * 2;
static_assert(A_U + (size_t)MT * DFF * 2 <= A_END + 64 * MiB, "overlay");
constexpr size_t WS_END = WS_ACT + 240 * MiB;
static_assert(WS_W + 2 * W_LAYER <= WS_H && WS_H + (size_t)MT * DM * 2 <= WS_ACT && A_END <= 240 * MiB && A_U + (size_t)MT * DFF * 2 <= 240 * MiB, "d_ws map");
constexpr int CW_BAR = 1024;

namespace pg8 {
#define PG8_LAS __attribute__((address_space(3)))
typedef unsigned short bf16_t;
typedef short bf16x8 __attribute__((ext_vector_type(8)));
typedef float f32x4 __attribute__((ext_vector_type(4)));
typedef unsigned u32x4 __attribute__((ext_vector_type(4)));
constexpr int BM = 256, BK = 64, HALF = 128, HTB = HALF * BK * 2  , STAGE_BYTES = 8 * HTB, NXCD = 8, WGM = 8;

__host__ __device__ __forceinline__ int lds_byte(int r, int c) { const int st = (r >> 4) * 2 + (c >> 5), rr = r & 15, cc = c & 31, ob = rr * 64 + cc * 2; return st * 1024 + (ob ^ (((ob >> 9) & 1) << 5)); }
__host__ __device__ __forceinline__ void stage_rc(int b, int& R, int& C) { const int st = b / 1024, sb = b % 1024, swz = sb ^ (((sb >> 9) & 1) << 5); R = (st >> 1) * 16 + swz / 64; C = (st & 1) * 32 + (swz % 64) / 2; }
__host__ __device__ __forceinline__ int perm32(int rho) { const int n = rho >> 4, i = rho & 15; return 8 * (i >> 2) + 4 * n + (i & 3); }

struct Unit { int pm, pn; };
struct Gemm { const bf16_t* A; const bf16_t* Bt; int M, N, K; };

struct StaticOrder {
    int nM, nN, nwg, G, c;
    __host__ __device__ void init(int M, int N, int G_, int c_) { nM = M / BM; nN = N / BM; nwg = nM * nN; G = G_; c = c_; }
    __host__ __device__ bool next(int i, Unit& u) const {
        const long L = (long)i * G + c; if (L >= nwg) return false;
        int wgid = (int)L; { const int q = nwg / NXCD, r = nwg % NXCD, xcd = wgid % NXCD, off = wgid / NXCD; wgid = (xcd < r ? xcd * (q + 1) : r * (q + 1) + (xcd - r) * q) + off; }
        const int nig = WGM * nN, gid = wgid / nig, fm = gid * WGM, gsz = (nM - fm) < WGM ? (nM - fm) : WGM;
        u.pm = fm + ((wgid % nig) % gsz); u.pn = (wgid % nig) / gsz; return true;
    }
    __device__ __forceinline__ void a_ready(const Unit&) const {}
    __device__ __forceinline__ void done(const Unit&) const {}
};


__device__ __forceinline__ unsigned cvt_pk_bf16(float lo, float hi) { unsigned r; asm volatile("v_cvt_pk_bf16_f32 %0, %1, %2" : "=v"(r) : "v"(lo), "v"(hi)); return r; }
__device__ __forceinline__ float bf_lo(unsigned w) { return __uint_as_float(w << 16); }
__device__ __forceinline__ float bf_hi(unsigned w) { return __uint_as_float(w & 0xffff0000u); }
__device__ __forceinline__ float gelu_tanh(float x) {
    const float u = x * (0.7978845608028654f + 0.035677408136300125f * x * x);
    return x * __builtin_amdgcn_rcpf(1.0f + __builtin_amdgcn_exp2f(-2.0f * LOG2E * u));
}
__device__ __forceinline__ u32x4 pack8(const f32x4 a, const f32x4 b) { u32x4 w; w.x = cvt_pk_bf16(a[0], a[1]); w.y = cvt_pk_bf16(a[2], a[3]); w.z = cvt_pk_bf16(b[0], b[1]); w.w = cvt_pk_bf16(b[2], b[3]); return w; }

struct EpiIn {
    static constexpr bool PERM = true, AFTER_DRAIN = false, MIDK = false;
    unsigned char* act; float* VSS; float* out; const float* qg; const float* kg; int layer;
    __device__ __forceinline__ void operator()(const f32x4 (&acc)[2][2][4][2], const Unit& u, int wr, int wc, int fr, int fq) const {
        const int pn = u.pn, rowt = u.pm * BM + wr * 64 + fr;
        if (pn < 6) {
            const int which = pn >> 1, half = pn & 1;
            bf16_t* dst = (bf16_t*)(act + A_Q) + (size_t)which * ((size_t)MT * 512);
            const int colb = half * 256 + 64 * wc + 8 * fq;
            f32x4 gv[2][2];
#pragma unroll
            for (int bj = 0; bj < 2; ++bj)
#pragma unroll
                for (int n = 0; n < 2; ++n) gv[bj][n] = *(const f32x4*)((which == 0 ? qg : kg) + 32 * bj + 8 * fq + 4 * n);
            float* fo = nullptr;
            if (which >= 1) {
                if (u.pm < 64) { if ((u.pm & 31) >= 30) fo = out + O_KP + (size_t)(which - 1) * (O_VP - O_KP) + ((size_t)(layer * NBATCH + (u.pm >> 5)) * 512 + ((u.pm & 31) - 30) * 256 + wr * 64 + fr) * 512 + colb; }
                else fo = out + O_KS + (size_t)(which - 1) * (O_VS - O_KS) + (size_t)layer * (DECB * DECT * 512) + (size_t)((u.pm - 64) * 256 + wr * 64 + fr) * 512 + colb;
            }
#pragma unroll
            for (int ai = 0; ai < 2; ++ai)
#pragma unroll
                for (int m = 0; m < 4; ++m) {
                    f32x4 v[2][2];
#pragma unroll
                    for (int bj = 0; bj < 2; ++bj)
#pragma unroll
                        for (int n = 0; n < 2; ++n) v[bj][n] = acc[ai][bj][m][n];
                    if (which < 2) {
                        float ss = 0.f;
#pragma unroll
                        for (int bj = 0; bj < 2; ++bj)
#pragma unroll
                            for (int n = 0; n < 2; ++n) ss += (v[bj][n][0] * v[bj][n][0] + v[bj][n][1] * v[bj][n][1]) + (v[bj][n][2] * v[bj][n][2] + v[bj][n][3] * v[bj][n][3]);
                        ss += __shfl_xor(ss, 16); ss += __shfl_xor(ss, 32);
                        const float rs = __builtin_amdgcn_rsqf(ss * (1.0f / 64.0f) + EPS);
#pragma unroll
                        for (int bj = 0; bj < 2; ++bj)
#pragma unroll
                            for (int n = 0; n < 2; ++n) v[bj][n] = v[bj][n] * rs * gv[bj][n];
                    }
                    const size_t roff = (size_t)(ai * HALF + m * 16);
                    if (fo) {
#pragma unroll
                        for (int bj = 0; bj < 2; ++bj) { *(f32x4*)(fo + roff * 512 + 32 * bj) = v[bj][0]; *(f32x4*)(fo + roff * 512 + 32 * bj + 4) = v[bj][1]; }
                    }
                    const float sc = which == 0 ? QSCALE : 1.0f;
                    bf16_t* rp = dst + ((size_t)rowt + roff) * 512 + colb;
#pragma unroll
                    for (int bj = 0; bj < 2; ++bj) *(u32x4*)(rp + 32 * bj) = pack8(v[bj][0] * sc, v[bj][1] * sc);
                }
        } else if (pn < 10) {
            const bool isv = pn >= 8;
            bf16_t* dst = (bf16_t*)(act + A_UB) + (isv ? (size_t)MT * 512 : 0);
            const int colb = (pn & 1) * 256 + 64 * wc + 8 * fq;
#pragma unroll
            for (int ai = 0; ai < 2; ++ai)
#pragma unroll
                for (int m = 0; m < 4; ++m) {
                    f32x4 v[2][2]; float ss = 0.f;
#pragma unroll
                    for (int bj = 0; bj < 2; ++bj)
#pragma unroll
                        for (int n = 0; n < 2; ++n) {
#pragma unroll
                            for (int e = 0; e < 4; ++e) { const float g = gelu_tanh(acc[ai][bj][m][n][e]); v[bj][n][e] = g; ss += g * g; } }
                    const size_t row = (size_t)rowt + ai * HALF + m * 16;
                    if (isv) { ss += __shfl_xor(ss, 16); ss += __shfl_xor(ss, 32); if (fq == 0) VSS[row * 8 + (pn & 1) * 4 + wc] = ss; }
                    bf16_t* rp = dst + row * 512 + colb;
#pragma unroll
                    for (int bj = 0; bj < 2; ++bj) *(u32x4*)(rp + 32 * bj) = pack8(v[bj][0], v[bj][1]);
                }
        } else {
            const int ch = 128 * (pn - 10) + 32 * wc + 8 * fq;
#pragma unroll
            for (int ai = 0; ai < 2; ++ai)
#pragma unroll
                for (int m = 0; m < 4; ++m) {
                    f32x4 r[2], g[2];
#pragma unroll
                    for (int n = 0; n < 2; ++n)
#pragma unroll
                        for (int e = 0; e < 4; ++e) {
                            const float za = fminf(fmaxf(acc[ai][0][m][n][e], -30.f), 30.f), zb = fminf(fmaxf(acc[ai][1][m][n][e], -30.f), 30.f);
                            const float ea = __builtin_amdgcn_exp2f(-LOG2E * za), eb = __builtin_amdgcn_exp2f(-LOG2E * zb);
                            g[n][e] = __builtin_amdgcn_rcpf(1.0f + eb); r[n][e] = (1.0f + eb) * __builtin_amdgcn_rcpf(1.0f + ea);
                        }
                    const size_t row = (size_t)rowt + ai * HALF + m * 16;
                    *(u32x4*)((bf16_t*)(act + A_GR) + row * DM + ch) = pack8(r[0], r[1]);
                    *(u32x4*)((bf16_t*)(act + A_GB) + row * DM + ch) = pack8(g[0], g[1]);
                }
        }
    }
};

struct EpiOutAB {
    static constexpr bool PERM = true, AFTER_DRAIN = false, MIDK = true;
    const bf16_t *GR, *GB; bf16_t* MIX;
    __device__ __forceinline__ void mid(f32x4 (&acc)[2][2][4][2], const Unit& u, int wr, int wc, int fr_, int fq_) const {
        int fr = fr_, fq = fq_; asm volatile("" : "+v"(fr), "+v"(fq));
        const int rowt = u.pm * BM + wr * 64 + fr, colb = u.pn * BM + 32 * wc + 8 * fq;
#pragma unroll
        for (int ai = 0; ai < 2; ++ai)
#pragma unroll
            for (int m = 0; m < 4; ++m) {
                const bf16_t* rp = GR + ((size_t)rowt + ai * HALF + m * 16) * DM + colb;
#pragma unroll
                for (int bj = 0; bj < 2; ++bj) { const u32x4 w = *(const u32x4*)(rp + bj * HALF);
                    acc[ai][bj][m][0] = acc[ai][bj][m][0] * (f32x4){bf_lo(w.x), bf_hi(w.x), bf_lo(w.y), bf_hi(w.y)};
                    acc[ai][bj][m][1] = acc[ai][bj][m][1] * (f32x4){bf_lo(w.z), bf_hi(w.z), bf_lo(w.w), bf_hi(w.w)}; }
                if (m & 1) asm volatile("" ::: "memory");
            }
    }
    __device__ __forceinline__ void operator()(const f32x4 (&acc)[2][2][4][2], const Unit& u, int wr, int wc, int fr, int fq) const {
        const int rowt = u.pm * BM + wr * 64 + fr, colb = u.pn * BM + 32 * wc + 8 * fq;
#pragma unroll
        for (int ai = 0; ai < 2; ++ai)
#pragma unroll
            for (int m = 0; m < 4; ++m) {
                const size_t ro = ((size_t)rowt + ai * HALF + m * 16) * DM + colb;
#pragma unroll
                for (int bj = 0; bj < 2; ++bj) { const u32x4 w = *(const u32x4*)(GB + ro + bj * HALF);
                    const f32x4 a = acc[ai][bj][m][0] * (f32x4){bf_lo(w.x), bf_hi(w.x), bf_lo(w.y), bf_hi(w.y)};
                    const f32x4 b = acc[ai][bj][m][1] * (f32x4){bf_lo(w.z), bf_hi(w.z), bf_lo(w.w), bf_hi(w.w)};
                    *(u32x4*)(MIX + ro + bj * HALF) = pack8(a, b); }
            }
    }
};

struct EpiRes {
    static constexpr bool PERM = true, AFTER_DRAIN = false, MIDK = false;
    const float* xin_p; const float* xin_s; float* xout; const float* gate;
    __device__ __forceinline__ void operator()(const f32x4 (&acc)[2][2][4][2], const Unit& u, int wr, int wc, int fr, int fq) const {
        const bool smp = u.pm >= 64;
        const int rowt = u.pm * BM + wr * 64 + fr, colb = u.pn * BM + 32 * wc + 8 * fq;
        const float* xin = smp ? xin_s - (size_t)MP * DM : xin_p;
#pragma unroll
        for (int ai = 0; ai < 2; ++ai)
#pragma unroll
            for (int m = 0; m < 4; ++m) {
                const int row = rowt + ai * HALF + m * 16;
                const int bidx = smp ? NBATCH + ((row - MP) >> 4) : (u.pm >> 5);
                const float* gp = gate + (size_t)bidx * 6144 + colb;
                const size_t ro = (size_t)row * DM + colb;
#pragma unroll
                for (int bj = 0; bj < 2; ++bj)
#pragma unroll
                    for (int n = 0; n < 2; ++n) {
                        const f32x4 g = *(const f32x4*)(gp + bj * HALF + 4 * n), x = *(const f32x4*)(xin + ro + bj * HALF + 4 * n);
                        *(f32x4*)(xout + ro + bj * HALF + 4 * n) = x + g * acc[ai][bj][m][n];
                    }
            }
    }
};

struct EpiFfnIn {
    static constexpr bool PERM = true, AFTER_DRAIN = false, MIDK = false;
    bf16_t *G, *U; float* out; int layer;
    __device__ __forceinline__ void operator()(const f32x4 (&acc)[2][2][4][2], const Unit& u, int wr, int wc, int fr, int fq) const {
        const bool smp = u.pm >= 64;
        const int rowt = u.pm * BM + wr * 64 + fr, ch = u.pn * HALF + 32 * wc + 8 * fq;
#pragma unroll
        for (int ai = 0; ai < 2; ++ai)
#pragma unroll
            for (int m = 0; m < 4; ++m) {
                const int row = rowt + ai * HALF + m * 16;
                const size_t ro = (size_t)row * DFF + ch;
                *(u32x4*)(G + ro) = pack8(acc[ai][0][m][0], acc[ai][0][m][1]);
                *(u32x4*)(U + ro) = pack8(acc[ai][1][m][0], acc[ai][1][m][1]);
                if (fr >= 14) {
                    float* fo = nullptr;
                    if (smp) fo = out + O_CS + ((size_t)(layer * DECB + ((row - MP) >> 4)) * 2 + (fr - 14)) * DFF + ch;
                    else if ((u.pm & 31) == 31 && ai == 1 && wr == 1 && m == 3) fo = out + O_CP + ((size_t)(layer * NBATCH + (u.pm >> 5)) * 2 + (fr - 14)) * DFF + ch;
                    if (fo) { *(f32x4*)fo = acc[ai][0][m][0]; *(f32x4*)(fo + 4) = acc[ai][0][m][1]; }
                }
            }
    }
};

template <class Epi, class Sched, bool ALIGN_EPI = false, bool SP2 = false>
__device__ __forceinline__ void gemm_phase(PG8_LAS unsigned char* lds, const Gemm g, const Sched& S, const Epi& E) {
    int tid_o = threadIdx.x; asm volatile("" : "+v"(tid_o));
    const int tid = tid_o, wid = __builtin_amdgcn_readfirstlane(tid >> 6), lane = tid & 63, wr = wid >> 2, wc = wid & 3, fr = lane & 15, fq = lane >> 4;
    const int K = g.K, nt = K / BK;
    unsigned voffA[2], voffB[2];
#pragma unroll
    for (int i = 0; i < 2; ++i) { int R, C; stage_rc(tid * 16 + i * 8192, R, C); const int Rb = Epi::PERM ? ((R & ~31) + perm32(R & 31)) : R;
        voffA[i] = (unsigned)(R * K + C) * 2u; voffB[i] = (unsigned)(Rb * K + C) * 2u; }
    const size_t kstep = (size_t)(BK * 2);
    const size_t hstep = (size_t)HALF * K * 2;
    const size_t tstep = 2 * hstep;
    const unsigned ldsw = (unsigned)wid * 1024u;
    const int aoff = lds_byte(wr * 64 + fr, fq * 8), boff = lds_byte(wc * 32 + fr, fq * 8);
#define PG8_SA(b, h) (((b) * 2 + (h)) * HTB)
#define PG8_SB(b, h) ((4 + (b) * 2 + (h)) * HTB)
#define PG8_STAGE(bufoff, gbase, voff) do { _Pragma("unroll") for (int _i = 0; _i < 2; ++_i) \
        __builtin_amdgcn_global_load_lds((const unsigned*)((const char*)(gbase) + (voff)[_i]), (PG8_LAS unsigned*)(lds + (bufoff) + ldsw + _i * 8192), 16, 0, 0); } while (0)
#define PG8_LDA(dst, b, h) do { _Pragma("unroll") for (int m = 0; m < 4; ++m) _Pragma("unroll") for (int k = 0; k < 2; ++k) dst[m][k] = *(const PG8_LAS bf16x8*)(lds + PG8_SA(b, h) + aoff + m * 2048 + k * 1024); } while (0)
#define PG8_LDB(dst, b, h) do { _Pragma("unroll") for (int n = 0; n < 2; ++n) _Pragma("unroll") for (int k = 0; k < 2; ++k) dst[n][k] = *(const PG8_LAS bf16x8*)(lds + PG8_SB(b, h) + boff + n * 2048 + k * 1024); } while (0)
#define PG8_MMA(ai, bj, At, Bt) do { __builtin_amdgcn_s_setprio(1); _Pragma("unroll") for (int m = 0; m < 4; ++m) _Pragma("unroll") for (int n = 0; n < 2; ++n) _Pragma("unroll") for (int k = 0; k < 2; ++k) \
        acc[ai][bj][m][n] = __builtin_amdgcn_mfma_f32_16x16x32_bf16(Bt[n][k], At[m][k], acc[ai][bj][m][n], 0, 0, 0); __builtin_amdgcn_s_setprio(0); } while (0)
#define PG8_WAIT_V(n) asm volatile("s_waitcnt vmcnt(" #n ")" ::: "memory")
#define PG8_WAIT_L(n) asm volatile("s_waitcnt lgkmcnt(" #n ")" ::: "memory")
#define PG8_BAR __builtin_amdgcn_s_barrier()
#define PG8_SCHED __builtin_amdgcn_sched_barrier(0)
    Unit cur, nxt; int ui = 0;
    if (!S.next(0, cur)) return;
    f32x4 acc[2][2][4][2];
#pragma unroll
    for (int a = 0; a < 2; ++a)
#pragma unroll
        for (int b = 0; b < 2; ++b)
#pragma unroll
            for (int m = 0; m < 4; ++m)
#pragma unroll
                for (int n = 0; n < 2; ++n) acc[a][b][m][n] = (f32x4){0.f, 0.f, 0.f, 0.f};
    bf16x8 At[4][2], B0[2][2], B1[2][2];
    const char* cA = (const char*)g.A + (size_t)cur.pm * tstep; const char* cB = (const char*)g.Bt + (size_t)cur.pn * tstep;
    S.a_ready(cur);
    if constexpr (SP2) {
        PG8_STAGE(PG8_SB(0, 0), cB, voffB); PG8_STAGE(PG8_SB(0, 1), cB + hstep, voffB); PG8_STAGE(PG8_SA(0, 0), cA, voffA); PG8_STAGE(PG8_SA(0, 1), cA + hstep, voffA);
        if (wr == 1) PG8_BAR;
        PG8_WAIT_V(2); PG8_BAR;
        PG8_STAGE(PG8_SB(1, 0), cB + kstep, voffB); PG8_STAGE(PG8_SA(1, 0), cA + kstep, voffA); PG8_STAGE(PG8_SB(1, 1), cB + hstep + kstep, voffB);
        PG8_WAIT_V(6); PG8_BAR;
    } else {
        PG8_STAGE(PG8_SB(0, 0), cB, voffB); PG8_STAGE(PG8_SA(0, 0), cA, voffA); PG8_STAGE(PG8_SB(0, 1), cB + hstep, voffB); PG8_STAGE(PG8_SA(0, 1), cA + hstep, voffA);
        if (wr == 1) PG8_BAR;
        PG8_WAIT_V(4); PG8_BAR;
        PG8_STAGE(PG8_SB(1, 0), cB + kstep, voffB); PG8_STAGE(PG8_SA(1, 0), cA + kstep, voffA); PG8_STAGE(PG8_SB(1, 1), cB + hstep + kstep, voffB);
        PG8_WAIT_V(6); PG8_BAR;
    }
    for (;;) {
        const bool has_next = S.next(ui + 1, nxt);
        const char* nA = has_next ? (const char*)g.A + (size_t)nxt.pm * tstep : cA; const char* nB = has_next ? (const char*)g.Bt + (size_t)nxt.pn * tstep : cB;
        for (int t = 0; t < nt; t += 2) {
            const bool last = (t == nt - 2);
            const char* a1 = cA + (size_t)(t + 1) * kstep;
            const char* a2 = last ? nA : cA + (size_t)(t + 2) * kstep; const char* b2 = last ? nB : cB + (size_t)(t + 2) * kstep;
            const char* a3 = a2 + kstep; const char* b3 = b2 + kstep;
            if (last && has_next) S.a_ready(nxt);
            if constexpr (Epi::MIDK) { if (t == (nt >> 1)) E.mid(acc, cur, wr, wc, fr, fq); }
            if constexpr (SP2) {
            PG8_LDB(B0, 0, 0); PG8_LDB(B1, 0, 1); PG8_SCHED; PG8_LDA(At, 0, 0); PG8_STAGE(PG8_SA(1, 1), a1 + hstep, voffA);
            PG8_WAIT_V(8); PG8_WAIT_L(0); PG8_BAR; PG8_MMA(0, 0, At, B0); PG8_MMA(0, 1, At, B1); PG8_BAR; PG8_SCHED;
            PG8_LDA(At, 0, 1); PG8_STAGE(PG8_SB(0, 0), b2, voffB); PG8_STAGE(PG8_SB(0, 1), b2 + hstep, voffB); PG8_STAGE(PG8_SA(0, 0), a2, voffA);
            PG8_WAIT_V(8); PG8_WAIT_L(0); PG8_BAR; PG8_MMA(1, 0, At, B0); PG8_MMA(1, 1, At, B1); PG8_BAR; PG8_SCHED;
            PG8_LDB(B0, 1, 0); PG8_LDB(B1, 1, 1); PG8_SCHED; PG8_LDA(At, 1, 0); PG8_STAGE(PG8_SA(0, 1), a2 + hstep, voffA);
            PG8_WAIT_V(8); PG8_WAIT_L(0); PG8_BAR; PG8_MMA(0, 0, At, B0); PG8_MMA(0, 1, At, B1); PG8_BAR; PG8_SCHED;
            PG8_LDA(At, 1, 1); PG8_STAGE(PG8_SB(1, 0), b3, voffB); PG8_STAGE(PG8_SB(1, 1), b3 + hstep, voffB); PG8_STAGE(PG8_SA(1, 0), a3, voffA);
            PG8_WAIT_V(8); PG8_WAIT_L(0); PG8_BAR; PG8_MMA(1, 0, At, B0); PG8_MMA(1, 1, At, B1); PG8_BAR; PG8_SCHED;
            } else {
            PG8_LDB(B0, 0, 0); PG8_SCHED; PG8_LDA(At, 0, 0); PG8_STAGE(PG8_SA(1, 1), a1 + hstep, voffA);
            PG8_WAIT_L(8); PG8_BAR; PG8_WAIT_L(0); PG8_MMA(0, 0, At, B0); PG8_BAR; PG8_SCHED;
            PG8_LDB(B1, 0, 1); PG8_STAGE(PG8_SB(0, 0), b2, voffB);
            PG8_BAR; PG8_WAIT_L(0); PG8_MMA(0, 1, At, B1); PG8_BAR;
            PG8_LDA(At, 0, 1); PG8_STAGE(PG8_SA(0, 0), a2, voffA);
            PG8_BAR; PG8_WAIT_L(0); PG8_MMA(1, 0, At, B0); PG8_BAR; PG8_SCHED;
            PG8_STAGE(PG8_SB(0, 1), b2 + hstep, voffB);
            PG8_WAIT_V(6); PG8_BAR; PG8_MMA(1, 1, At, B1); PG8_BAR;
            PG8_LDB(B0, 1, 0); PG8_SCHED; PG8_LDA(At, 1, 0); PG8_STAGE(PG8_SA(0, 1), a2 + hstep, voffA);
            PG8_WAIT_L(8); PG8_BAR; PG8_WAIT_L(0); PG8_MMA(0, 0, At, B0); PG8_BAR; PG8_SCHED;
            PG8_LDB(B1, 1, 1); PG8_STAGE(PG8_SB(1, 0), b3, voffB);
            PG8_BAR; PG8_WAIT_L(0); PG8_MMA(0, 1, At, B1); PG8_BAR;
            PG8_LDA(At, 1, 1); PG8_STAGE(PG8_SA(1, 0), a3, voffA);
            PG8_BAR; PG8_WAIT_L(0); PG8_MMA(1, 0, At, B0); PG8_BAR; PG8_SCHED;
            PG8_STAGE(PG8_SB(1, 1), b3 + hstep, voffB);
            PG8_WAIT_V(6); PG8_BAR; PG8_MMA(1, 1, At, B1); PG8_BAR;
            }
        }
        if constexpr (ALIGN_EPI) { if (wr == 0) PG8_BAR; }
        if constexpr (!Epi::AFTER_DRAIN) { E(acc, cur, wr, wc, fr, fq); S.done(cur); }
        if (!has_next) break;
#pragma unroll
        for (int a = 0; a < 2; ++a)
#pragma unroll
            for (int b = 0; b < 2; ++b)
#pragma unroll
                for (int m = 0; m < 4; ++m)
#pragma unroll
                    for (int n = 0; n < 2; ++n) acc[a][b][m][n] = (f32x4){0.f, 0.f, 0.f, 0.f};
        cur = nxt; cA = nA; cB = nB; ++ui;
        if constexpr (ALIGN_EPI) { if (wr == 1) PG8_BAR; }
    }
    PG8_WAIT_V(0);
    if constexpr (!ALIGN_EPI) { if (wr == 0) PG8_BAR; }
    PG8_BAR;
    if constexpr (Epi::AFTER_DRAIN) { E.fused(acc, cur, wr, wc, fr, fq, lds, wid, lane); S.done(cur); }
#undef PG8_SA
#undef PG8_SB
#undef PG8_STAGE
#undef PG8_LDA
#undef PG8_LDB
#undef PG8_MMA
#undef PG8_WAIT_V
#undef PG8_WAIT_L
#undef PG8_BAR
#undef PG8_SCHED
}
}
#define GAS __attribute__((address_space(1)))
#define LAS __attribute__((address_space(3)))
typedef unsigned short bf16;
typedef unsigned v4u __attribute__((ext_vector_type(4)));
typedef float f32x4 __attribute__((ext_vector_type(4)));
typedef short bf16x8 __attribute__((ext_vector_type(8)));
typedef GAS unsigned gu32;
typedef GAS unsigned long long gu64;
#define RLX_AGENT __ATOMIC_RELAXED, __HIP_MEMORY_SCOPE_AGENT
#define LDS_WAIT() asm volatile("s_waitcnt lgkmcnt(0)" ::: "memory")
#define VM_WAIT() asm volatile("s_waitcnt vmcnt(0)" ::: "memory")
__device__ __forceinline__ unsigned long long rt() { return __builtin_amdgcn_s_memrealtime(); }
__device__ __forceinline__ unsigned f2bf(float f) { unsigned u = __builtin_bit_cast(unsigned, f); return (u + 0x7fffu + ((u >> 16) & 1u)) >> 16; }
__device__ __forceinline__ unsigned pk2(float lo, float hi) { return f2bf(lo) | (f2bf(hi) << 16); }

#define XB_TMO      128
#define XB_XCNT(j)  (256  + 64 * (j))
#define XB_XSUB(j)  (1280 + 64 * (j))
#define XB_XGEN(j)  (2304 + 64 * (j))
#define XB_TOP      3328
#define XB_TOPGEN   3392
#define XCD_BAR_WORDS 3456
#define XB_SPIN_CAP (1u << 18)

__device__ __forceinline__ unsigned xb_ld(unsigned* p)              { return __hip_atomic_load(p, __ATOMIC_RELAXED, __HIP_MEMORY_SCOPE_AGENT); }
__device__ __forceinline__ unsigned xb_add(unsigned* p, unsigned v) { return __hip_atomic_fetch_add(p, v, __ATOMIC_RELAXED, __HIP_MEMORY_SCOPE_AGENT); }
__device__ __forceinline__ unsigned xb_xcc_id() { return (unsigned)__builtin_amdgcn_s_getreg((3 << 11) | 20) & 0xFu; }
#define XB_SPIN(cond, bar) do { unsigned _sp = 0; while (cond) { __builtin_amdgcn_s_sleep(1); \
    if ((++_sp & 255u) == 0u) { if (xb_ld(&(bar)[XB_TMO])) break; if (_sp > XB_SPIN_CAP) { atomicAdd(&(bar)[XB_TMO], 1u); break; } } } } while (0)

struct XcdBarrier {
    unsigned* bar; unsigned x;
    volatile LAS unsigned* st;
};

__device__ __forceinline__ XcdBarrier xcd_barrier_post(unsigned* bar, volatile LAS unsigned* st) {
    XcdBarrier b; b.bar = bar; b.x = xb_xcc_id(); b.st = st;
    if (threadIdx.x == 0) (void)xb_add(&bar[XB_XCNT(b.x)], 1u);
    return b;
}
__device__ __forceinline__ void xcd_barrier_complete(unsigned* bar, unsigned x, unsigned& nloc, unsigned& nx) {
    const unsigned G = gridDim.x * gridDim.y * gridDim.z;
    unsigned sum, cnt, mine, sp = 0u;
    for (;;) {
        sum = 0u; cnt = 0u; mine = 0u;
#pragma unroll
        for (unsigned j = 0; j < 16; ++j) { const unsigned c = xb_ld(&bar[XB_XCNT(j)]); sum += c; cnt += (c > 0u) ? 1u : 0u; mine = (j == x) ? c : mine; }
        if (sum == G) break;
        __builtin_amdgcn_s_sleep(1);
        if ((++sp & 255u) == 0u) { if (xb_ld(&bar[XB_TMO])) break; if (sp > XB_SPIN_CAP) { atomicAdd(&bar[XB_TMO], 1u); break; } }
    }
    nloc = mine > 0u ? mine : 1u; nx = cnt > 0u ? cnt : 1u;
}

__device__ __forceinline__ void xcd_barrier(const XcdBarrier& b) {
    asm volatile("s_waitcnt vmcnt(0)" ::: "memory");
    __syncthreads();
    if (threadIdx.x == 0) {
        unsigned* bar = b.bar;
        __builtin_amdgcn_s_waitcnt(0);
        unsigned nloc = b.st[0], nx = b.st[1];
        if (nloc == 0u) { xcd_barrier_complete(bar, b.x, nloc, nx); b.st[0] = nloc; b.st[1] = nx; }
        const unsigned old = xb_add(&bar[XB_XSUB(b.x)], 1u);
        const unsigned gen = old / nloc;
        if (old + 1u == (gen + 1u) * nloc) {
            __builtin_amdgcn_fence(__ATOMIC_RELEASE, "agent");
            asm volatile("s_waitcnt vmcnt(0)" ::: "memory");
            const unsigned og = xb_add(&bar[XB_TOP], 1u);
            const unsigned tg = og / nx;
            if (og + 1u == (tg + 1u) * nx) xb_add(&bar[XB_TOPGEN], 1u);
            else XB_SPIN(xb_ld(&bar[XB_TOPGEN]) == tg, bar);
            __builtin_amdgcn_fence(__ATOMIC_ACQUIRE, "agent");
            xb_add(&bar[XB_XGEN(b.x)], 1u);
            asm volatile("s_waitcnt vmcnt(0)" ::: "memory");
        } else {
            XB_SPIN(xb_ld(&bar[XB_XGEN(b.x)]) == gen, bar);
            __builtin_amdgcn_fence(__ATOMIC_ACQUIRE, "agent");
            asm volatile("s_waitcnt vmcnt(0)" ::: "memory");
        }
    }
    __syncthreads();
}

constexpr int NWAVES = 8;
typedef float f32x16 __attribute__((ext_vector_type(16)));
typedef short s16x4 __attribute__((ext_vector_type(4)));
typedef unsigned u32x2 __attribute__((ext_vector_type(2)));

constexpr int RING_BYTES = 131072;
constexpr int LDSCTL_OFF = 143360, MISC_OFF = LDSCTL_OFF + 320;
constexpr int LDS_BYTES = 147456;

struct Args { const float* in[25]; float* out; unsigned char* ws; int ph_lo, ph_hi; };
static_assert(sizeof(Args) == 25 * 8 + 8 + 8 + 8, "Args has no padding");
struct Frame {
    LAS unsigned char* lds;
    volatile LAS unsigned* MISC;
    gu32* ctl;
    int tid, lane, wave, vcu, G;
    float* out; unsigned char* ws;
};
#define F_IN_XP 0
#define F_IN_XS 1
#define F_IN_CK 2
#define F_IN_CV 3
#define F_IN_CC 4
#define F_IN_CP 5
#define F_IN_CSM 6
#define F_IN_N1 7
#define F_IN_N2 8
#define F_IN_WADA 9
#define F_IN_BADA 10
#define F_IN_WIN 11
#define F_IN_QG 12
#define F_IN_KG 13
#define F_IN_RB 14
#define F_IN_VG 15
#define F_IN_WSP 16
#define F_IN_BSP 17
#define F_IN_WOA 18
#define F_IN_WOB 19
#define F_IN_WO 20
#define F_IN_WF1 21
#define F_IN_CW 22
#define F_IN_CB 23
#define F_IN_WF2 24

__device__ __forceinline__ float wave_sum(float v) {
#pragma unroll
    for (int o = 1; o < 64; o <<= 1) v += __shfl_xor(v, o);
    return v;
}
__device__ __forceinline__ unsigned cvtpk(float lo, float hi) { unsigned r; asm volatile("v_cvt_pk_bf16_f32 %0, %1, %2" : "=v"(r) : "v"(lo), "v"(hi)); return r; }
__device__ __forceinline__ float bflo(unsigned w) { return __uint_as_float(w << 16); }
__device__ __forceinline__ float bfhi(unsigned w) { return __uint_as_float(w & 0xffff0000u); }
__device__ __forceinline__ float gelu_t(float x) { const float u = x * (0.7978845608028654f + 0.035677408136300125f * x * x); return x * __builtin_amdgcn_rcpf(1.0f + __builtin_amdgcn_exp2f(-2.0f * LOG2E * u)); }

__device__ __forceinline__ void p0_transpose_item(const float* W, int ldw, int k0, int n0, bf16* WT, int ldk, int koff, int drow, LAS float* scr, int lane) {
#pragma unroll 8
    for (int i = 0; i < 32; ++i) { const int kk = 2 * i + (lane >> 5); scr[kk * 33 + (lane & 31)] = W[(size_t)(k0 + kk) * ldw + n0 + (lane & 31)]; }
    LDS_WAIT(); asm volatile("" ::: "memory");
    const int c = lane & 7;
#pragma unroll
    for (int j = 0; j < 4; ++j) { const int n = (lane >> 3) + 8 * j; const LAS float* s = scr + (8 * c) * 33 + n;
        v4u o; o.x = pk2(s[0 * 33], s[1 * 33]); o.y = pk2(s[2 * 33], s[3 * 33]); o.z = pk2(s[4 * 33], s[5 * 33]); o.w = pk2(s[6 * 33], s[7 * 33]);
        *(GAS v4u*)(WT + (size_t)(drow + n) * ldk + koff + k0 + 8 * c) = o; }
    LDS_WAIT(); asm volatile("" ::: "memory");
}
__device__ __forceinline__ int win_drow(int n0) {
    if (n0 < 2560) { const int tile = n0 >> 8, c = n0 & 255; return tile * 256 + 128 * ((c >> 5) & 1) + 32 * (c >> 6); }
    const int r = n0 - 2560, bj = r >> 10, ch = r & 1023; return 2560 + 256 * (ch >> 7) + 128 * bj + (ch & 127);
}
__device__ __forceinline__ int wf1_drow(int n0) { const int bj = n0 >= DFF ? 1 : 0, ch = n0 - bj * DFF; return 256 * (ch >> 7) + 128 * bj + (ch & 127); }

__device__ __forceinline__ void p0_weights(Frame& F, const Args& A) {
    LAS float* scr = (LAS float*)(F.lds + F.wave * 16384);
    const int gw = F.vcu * NWAVES + F.wave, NGW = F.G * NWAVES;
    constexpr int I_IN = (DM / 64) * (DIN / 32), I_OA = (DA / 64) * (DM / 32), I_OB = I_OA, I_O = (DM / 64) * (DM / 32), I_F1 = (DM / 64) * (2 * DFF / 32), I_F2 = (DFF / 64) * (DM / 32);
    constexpr int PER_L = I_IN + I_OA + I_OB + I_O + I_F1 + I_F2;
    for (int it = gw; it < DEPTH * PER_L; it += NGW) {
        const int l = it / PER_L; int r = it % PER_L;
        bf16* wl = (bf16*)(F.ws + WS_W + (size_t)l * W_LAYER);
        if (r < I_IN) { const int nb = DIN / 32, k0 = 64 * (r / nb), n0 = 32 * (r % nb); p0_transpose_item(A.in[F_IN_WIN] + (size_t)l * DM * DIN, DIN, k0, n0, (bf16*)((char*)wl + W_IN), DM, 0, win_drow(n0), scr, F.lane); continue; } r -= I_IN;
        if (r < I_OA) { const int nb = DM / 32, k0 = 64 * (r / nb), n0 = 32 * (r % nb); p0_transpose_item(A.in[F_IN_WOA] + (size_t)l * DA * DM, DM, k0, n0, (bf16*)((char*)wl + W_AB), DM, 0, n0, scr, F.lane); continue; } r -= I_OA;
        if (r < I_OB) { const int nb = DM / 32, k0 = 64 * (r / nb), n0 = 32 * (r % nb); p0_transpose_item(A.in[F_IN_WOB] + (size_t)l * DB * DM, DM, k0, n0, (bf16*)((char*)wl + W_AB), DM, DA, n0, scr, F.lane); continue; } r -= I_OB;
        if (r < I_O) { const int nb = DM / 32, k0 = 64 * (r / nb), n0 = 32 * (r % nb); p0_transpose_item(A.in[F_IN_WO] + (size_t)l * DM * DM, DM, k0, n0, (bf16*)((char*)wl + W_O), DM, 0, n0, scr, F.lane); continue; } r -= I_O;
        if (r < I_F1) { const int nb = 2 * DFF / 32, k0 = 64 * (r / nb), n0 = 32 * (r % nb); p0_transpose_item(A.in[F_IN_WF1] + (size_t)l * DM * 2 * DFF, 2 * DFF, k0, n0, (bf16*)((char*)wl + W_F1), DM, 0, wf1_drow(n0), scr, F.lane); continue; } r -= I_F1;
        { const int nb = DM / 32, k0 = 64 * (r / nb), n0 = 32 * (r % nb); p0_transpose_item(A.in[F_IN_WF2] + (size_t)l * DFF * DM, DM, k0, n0, (bf16*)((char*)wl + W_F2), DFF, 0, n0, scr, F.lane); }
    }
}
__device__ __forceinline__ void p0_mod(Frame& F, const Args& A) {
    LAS float* sc = (LAS float*)F.lds;
    __syncthreads();
    float* MOD = (float*)(F.ws + WS_MOD);
    constexpr int NITEM = DEPTH * (6 * DM / 64);
    bool staged = false;
    for (int it = F.vcu; it < NITEM; it += F.G) {
        if (!staged) {
            for (int i = F.tid; i < NMODB * DM; i += NWAVES * 64) { const int b = i >> 10, k = i & 1023;
                const float c = b < NBATCH ? A.in[F_IN_CP][b * DM + k] : A.in[F_IN_CSM][(b - NBATCH) * DM + k];
                sc[k * NMODB + b] = c * __builtin_amdgcn_rcpf(1.0f + __builtin_amdgcn_exp2f(-LOG2E * c)); }
            staged = true;
        }
        __syncthreads();
        const int l = it / 96, cg = it % 96, col = cg * 64 + F.lane;
        const float* W = A.in[F_IN_WADA] + (size_t)l * DM * 6144 + col;
        float acc[NMODB];
#pragma unroll
        for (int b = 0; b < NMODB; ++b) acc[b] = 0.f;
        const int kb = F.wave * 128;
#pragma unroll 4
        for (int k = 0; k < 128; ++k) {
            const float w = W[(size_t)(kb + k) * 6144];
            const LAS float* s = sc + (kb + k) * NMODB;
#pragma unroll
            for (int b = 0; b < NMODB; ++b) acc[b] += s[b] * w;
        }
        __syncthreads();
        LAS float* red = (LAS float*)F.lds;
#pragma unroll
        for (int b = 0; b < NMODB; ++b) red[(F.wave * NMODB + b) * 64 + F.lane] = acc[b];
        __syncthreads();
        for (int i = F.tid; i < NMODB * 64; i += NWAVES * 64) { float s = 0.f;
#pragma unroll
            for (int w = 0; w < NWAVES; ++w) s += red[w * NMODB * 64 + i];
            const int b = i >> 6, c = i & 63;
            MOD[((size_t)l * NMODB + b) * 6144 + cg * 64 + c] = s + A.in[F_IN_BADA][l * 6144 + cg * 64 + c]; }
        staged = false;
        __syncthreads();
    }
}
__device__ __forceinline__ void norm_pass(Frame& F, const Args& A, int layer, int which  , bool from_inputs) {
    int lane_ = F.lane; asm volatile("" : "+v"(lane_));
    const int gw = F.vcu * NWAVES + F.wave, NGW = F.G * NWAVES;
    const float* g = A.in[which ? F_IN_N2 : F_IN_N1] + layer * DM;
    const float* MOD = (const float*)(F.ws + WS_MOD) + (size_t)layer * NMODB * 6144 + (which ? 3 * DM : 0);
    bf16* H = (bf16*)(F.ws + WS_H);
    for (int row = gw; row < MT; row += NGW) {
        const float* xr = from_inputs ? (row < MP ? A.in[F_IN_XP] + (size_t)row * DM : A.in[F_IN_XS] + (size_t)(row - MP) * DM) : F.out + (size_t)row * DM;
        const int b = row < MP ? row / SEQ : NBATCH + ((row - MP) >> 4);
        const float* sh = MOD + (size_t)b * 6144; const float* scl = sh + DM;
        f32x4 v[4]; float ss = 0.f;
#pragma unroll
        for (int j = 0; j < 4; ++j) { v[j] = *((const f32x4*)xr + lane_ + 64 * j); ss += (v[j].x * v[j].x + v[j].y * v[j].y) + (v[j].z * v[j].z + v[j].w * v[j].w); }
        const float rstd = __builtin_amdgcn_rsqf(wave_sum(ss) * (1.f / DM) + EPS);
#pragma unroll
        for (int j = 0; j < 4; ++j) {
            const f32x4 gg = *((const f32x4*)g + lane_ + 64 * j), s1 = *((const f32x4*)scl + lane_ + 64 * j), s0 = *((const f32x4*)sh + lane_ + 64 * j);
            const f32x4 y = v[j] * rstd * gg * (s1 + 1.0f) + s0;
            u32x2 o; o.x = cvtpk(y.x, y.y); o.y = cvtpk(y.z, y.w);
            *((u32x2*)(H + (size_t)row * DM) + lane_ + 64 * j) = o;
        }
    }
}

__device__ __forceinline__ void conv_pass(Frame& F, const Args& A, int layer) {
    const bf16* G = (const bf16*)(F.ws + WS_ACT + A_G); bf16* U = (bf16*)(F.ws + WS_ACT + A_U);
    int lane_ = F.lane; asm volatile("" : "+v"(lane_));
    const int gw = F.vcu * NWAVES + F.wave, NGW = F.G * NWAVES;
    constexpr int NCG = DFF / 256, NRB = MT / 64;
    const float* cw = A.in[F_IN_CW] + (size_t)layer * 3 * DFF; const float* cb = A.in[F_IN_CB] + (size_t)layer * DFF;
    const float* cc = A.in[F_IN_CC] + (size_t)layer * DECB * 2 * DFF;
    for (int it = gw; it < NCG * NRB; it += NGW) {
        const int cg = it % NCG, rb = it / NCG;
        const int ch = cg * 256 + (lane_ & 31) * 8, t0 = rb * 64 + (lane_ >> 5) * 32;
        float w0[8], w1[8], w2[8], bb[8], g2[8], g1[8];
#pragma unroll
        for (int e = 0; e < 8; ++e) { w0[e] = cw[ch + e]; w1[e] = cw[DFF + ch + e]; w2[e] = cw[2 * DFF + ch + e]; bb[e] = cb[ch + e]; g2[e] = 0.f; g1[e] = 0.f; }
        for (int i = 0; i < 32; ++i) {
            const int row = t0 + i;
            const bool smp = row >= MP;
            const bool bs = smp ? (((row - MP) & 15) == 0) : ((row & (SEQ - 1)) == 0);
            if (bs) {
                if (smp) { const float* c0 = cc + (size_t)((row - MP) >> 4) * 2 * DFF + ch;
#pragma unroll
                    for (int e = 0; e < 8; ++e) { g2[e] = c0[e]; g1[e] = c0[DFF + e]; } }
                else {
#pragma unroll
                    for (int e = 0; e < 8; ++e) { g2[e] = 0.f; g1[e] = 0.f; } }
            } else if (i == 0) {
                const v4u a = *(const v4u*)(G + (size_t)(row - 2) * DFF + ch), b = *(const v4u*)(G + (size_t)(row - 1) * DFF + ch);
                g2[0] = bflo(a.x); g2[1] = bfhi(a.x); g2[2] = bflo(a.y); g2[3] = bfhi(a.y); g2[4] = bflo(a.z); g2[5] = bfhi(a.z); g2[6] = bflo(a.w); g2[7] = bfhi(a.w);
                g1[0] = bflo(b.x); g1[1] = bfhi(b.x); g1[2] = bflo(b.y); g1[3] = bfhi(b.y); g1[4] = bflo(b.z); g1[5] = bfhi(b.z); g1[6] = bflo(b.w); g1[7] = bfhi(b.w);
            }
            const v4u gv = *(const v4u*)(G + (size_t)row * DFF + ch), uv = *(const v4u*)(U + (size_t)row * DFF + ch);
            float g0[8], uu[8], y[8];
            g0[0] = bflo(gv.x); g0[1] = bfhi(gv.x); g0[2] = bflo(gv.y); g0[3] = bfhi(gv.y); g0[4] = bflo(gv.z); g0[5] = bfhi(gv.z); g0[6] = bflo(gv.w); g0[7] = bfhi(gv.w);
            uu[0] = bflo(uv.x); uu[1] = bfhi(uv.x); uu[2] = bflo(uv.y); uu[3] = bfhi(uv.y); uu[4] = bflo(uv.z); uu[5] = bfhi(uv.z); uu[6] = bflo(uv.w); uu[7] = bfhi(uv.w);
#pragma unroll
            for (int e = 0; e < 8; ++e) { const float c = bb[e] + w0[e] * g2[e] + w1[e] * g1[e] + w2[e] * g0[e]; y[e] = gelu_t(c) * uu[e]; g2[e] = g1[e]; g1[e] = g0[e]; }
            v4u o; o.x = cvtpk(y[0], y[1]); o.y = cvtpk(y[2], y[3]); o.z = cvtpk(y[4], y[5]); o.w = cvtpk(y[6], y[7]);
            *(v4u*)(U + (size_t)row * DFF + ch) = o;
        }
    }
}

constexpr int AT_K = 0, AT_V = 16384, AT_BT = 32768, AT_WS = 33792, AT_SLOT = 8192;
__device__ __forceinline__ int crow(int r, int hi) { return (r & 3) + 8 * (r >> 2) + 4 * hi; }
typedef short v4i16_t __attribute__((ext_vector_type(4)));
__device__ __forceinline__ s16x4 vtr(const LAS unsigned char* p) { return __builtin_bit_cast(s16x4, __builtin_amdgcn_ds_read_tr16_b64_v4i16((LAS v4i16_t*)p)); }
__device__ __forceinline__ float swapmax(float m) { auto rr = __builtin_amdgcn_permlane32_swap(__float_as_uint(m), __float_as_uint(m), false, false); return fmaxf(__uint_as_float(rr[0]), __uint_as_float(rr[1])); }
__device__ __forceinline__ float swapsum(float m) { auto rr = __builtin_amdgcn_permlane32_swap(__float_as_uint(m), __float_as_uint(m), false, false); return __uint_as_float(rr[0]) + __uint_as_float(rr[1]); }

struct AttnState { float m, l; f32x16 o[2]; };

__device__ __forceinline__ void attn_tile(LAS unsigned char* lds, int slot, const bf16x8 (&qr)[4], AttnState& st, int dj, int iq, float cb, int nkeys, int wave, int lane) {
    const int r32 = lane & 31, hi = lane >> 5;
    const LAS unsigned char* kb = lds + AT_K + slot * AT_SLOT + hi * 1024 + r32 * 16;
    f32x16 p0 = {}, p1 = {};
#pragma unroll
    for (int d0 = 0; d0 < 4; ++d0) {
        const bf16x8 b0 = *(const LAS bf16x8*)(kb + d0 * 2048), b1 = *(const LAS bf16x8*)(kb + d0 * 2048 + 512);
        p0 = __builtin_amdgcn_mfma_f32_32x32x16_bf16(b0, qr[d0], p0, 0, 0, 0);
        p1 = __builtin_amdgcn_mfma_f32_32x32x16_bf16(b1, qr[d0], p1, 0, 0, 0);
    }
    if (dj >= 3) {
#pragma unroll
        for (int r = 0; r < 16; ++r) { p0[r] += cb; p1[r] += cb; }
    } else {
        const LAS float* T = (const LAS float*)(lds + AT_BT) + (dj * 64 + iq + 63 - 4 * hi);
#pragma unroll
        for (int r = 0; r < 16; ++r) { const int kv = (r & 3) + 8 * (r >> 2); p0[r] += T[-kv]; p1[r] += T[-kv - 32]; }
    }
    if (nkeys < 64) {
#pragma unroll
        for (int r = 0; r < 16; ++r) { if (crow(r, hi) >= nkeys) p0[r] = -INFINITY; p1[r] = -INFINITY; }
    }
    float mx = p0[0];
#pragma unroll
    for (int r = 1; r < 16; ++r) mx = fmaxf(mx, p0[r]);
#pragma unroll
    for (int r = 0; r < 16; ++r) mx = fmaxf(mx, p1[r]);
    mx = swapmax(mx);
    const float mnew = fmaxf(st.m, mx), alpha = __builtin_amdgcn_exp2f(st.m - mnew);
    st.m = mnew;
    float rs = 0.f;
#pragma unroll
    for (int r = 0; r < 16; ++r) { p0[r] = __builtin_amdgcn_exp2f(p0[r] - mnew); p1[r] = __builtin_amdgcn_exp2f(p1[r] - mnew); rs += p0[r] + p1[r]; }
    st.l = st.l * alpha + rs;
    LAS float* wsf = (LAS float*)(lds + AT_WS) + wave * 64;
    if (hi == 0) wsf[r32] = alpha;
    LDS_WAIT(); asm volatile("" ::: "memory");
#pragma unroll
    for (int r = 0; r < 16; ++r) { const float a = wsf[crow(r, hi)]; st.o[0][r] *= a; st.o[1][r] *= a; }
    bf16x8 pa[4];
#pragma unroll
    for (int k = 0; k < 4; ++k) {
        v4u w;
        if (k < 2) { w.x = cvtpk(p0[8 * k + 0], p0[8 * k + 1]); w.y = cvtpk(p0[8 * k + 2], p0[8 * k + 3]); w.z = cvtpk(p0[8 * k + 4], p0[8 * k + 5]); w.w = cvtpk(p0[8 * k + 6], p0[8 * k + 7]); }
        else { const int q = k - 2; w.x = cvtpk(p1[8 * q + 0], p1[8 * q + 1]); w.y = cvtpk(p1[8 * q + 2], p1[8 * q + 3]); w.z = cvtpk(p1[8 * q + 4], p1[8 * q + 5]); w.w = cvtpk(p1[8 * q + 6], p1[8 * q + 7]); }
        pa[k] = __builtin_bit_cast(bf16x8, w);
    }
    const LAS unsigned char* vp = lds + AT_V + slot * AT_SLOT + ((lane >> 4) & 1) * 32 + (lane & 3) * 8 + (4 * hi + ((lane & 15) >> 2)) * 64;
#pragma unroll
    for (int d0 = 0; d0 < 2; ++d0)
#pragma unroll
        for (int ks = 0; ks < 4; ++ks) {
            const s16x4 lo = vtr(vp + d0 * 4096 + ks * 1024), hh = vtr(vp + d0 * 4096 + ks * 1024 + 512);
            const bf16x8 vf = (bf16x8){lo[0], lo[1], lo[2], lo[3], hh[0], hh[1], hh[2], hh[3]};
            st.o[d0] = __builtin_amdgcn_mfma_f32_32x32x16_bf16(pa[ks], vf, st.o[d0], 0, 0, 0);
        }
}
__device__ __forceinline__ void stage_kv_bf16(LAS unsigned char* lds, int slot, const bf16* Kb, const bf16* Vb, size_t row0, int nvalid, int h, int wave, int lane) {
    int kr = lane; if (kr >= nvalid) kr = nvalid - 1;
    __builtin_amdgcn_global_load_lds((const unsigned*)(Kb + (row0 + kr) * 512 + h * 64 + wave * 8), (LAS unsigned*)(lds + AT_K + slot * AT_SLOT + wave * 1024), 16, 0, 0);
    int vr = 16 * (wave & 3) + (lane >> 2); if (vr >= nvalid) vr = nvalid - 1;
    __builtin_amdgcn_global_load_lds((const unsigned*)(Vb + (row0 + vr) * 512 + h * 64 + (wave >> 2) * 32 + (lane & 3) * 8), (LAS unsigned*)(lds + AT_V + slot * AT_SLOT + wave * 1024), 16, 0, 0);
}
__device__ __forceinline__ void stage_bias(Frame& F, const Args& A, int layer, int h) {
    const float* rb = A.in[F_IN_RB] + ((size_t)layer * NH + h) * NREL;
    if (F.tid < 255) { int d = F.tid - 63; if (d > 128) d = 128; ((LAS float*)(F.lds + AT_BT))[F.tid] = LOG2E * rb[d + 128]; }
}
__device__ __forceinline__ void attn_store(Frame& F, int lane_, const AttnState& st, bf16* O, size_t orow0, int h, int nrows) {
    const int r32 = lane_ & 31, hi = lane_ >> 5;
    const float lt = swapsum(st.l);
    LAS float* wsf = (LAS float*)(F.lds + AT_WS) + F.wave * 64;
    if (hi == 0) wsf[r32] = __builtin_amdgcn_rcpf(lt);
    LDS_WAIT(); asm volatile("" ::: "memory");
#pragma unroll
    for (int r = 0; r < 16; ++r) { const int q = crow(r, hi); const float a = wsf[q];
        if (q < nrows) {
#pragma unroll
            for (int d0 = 0; d0 < 2; ++d0) O[(orow0 + q) * DM + h * 64 + d0 * 32 + r32] = (bf16)(cvtpk(st.o[d0][r] * a, 0.f) & 0xffffu); } }
    LDS_WAIT(); asm volatile("" ::: "memory");
}
__device__ __forceinline__ void attn_prompt_unit(Frame& F, const Args& A, int layer, int b, int h, int c0) {
    const bf16* Q = (const bf16*)(F.ws + WS_ACT + A_Q); const bf16* Kb = (const bf16*)(F.ws + WS_ACT + A_K); const bf16* Vb = (const bf16*)(F.ws + WS_ACT + A_V);
    bf16* O = (bf16*)(F.ws + WS_ACT + A_OAB);
    int lane_ = F.lane; asm volatile("" : "+v"(lane_));
    const int r32 = lane_ & 31, hi = lane_ >> 5, ci = c0 + (F.wave >> 1), iq = 32 * (F.wave & 1) + r32;
    const size_t qrow = (size_t)b * SEQ + c0 * 64 + F.wave * 32;
    stage_bias(F, A, layer, h);
    const float cb = LOG2E * A.in[F_IN_RB][((size_t)layer * NH + h) * NREL + 256];
    bf16x8 qr[4];
#pragma unroll
    for (int d0 = 0; d0 < 4; ++d0) qr[d0] = *(const bf16x8*)(Q + (qrow + r32) * 512 + h * 64 + d0 * 16 + hi * 8);
    AttnState st; st.m = -INFINITY; st.l = 0.f; st.o[0] = f32x16{}; st.o[1] = f32x16{};
    const int jlo = c0 >= 8 ? c0 - 8 : 0, jhi = c0 + 3;
    stage_kv_bf16(F.lds, 0, Kb, Vb, (size_t)b * SEQ + jlo * 64, 64, h, F.wave, lane_);
    VM_WAIT(); __syncthreads();
    for (int jt = jlo; jt <= jhi; ++jt) {
        const int slot = (jt - jlo) & 1;
        if (jt < jhi) stage_kv_bf16(F.lds, slot ^ 1, Kb, Vb, (size_t)b * SEQ + (jt + 1) * 64, 64, h, F.wave, lane_);
        const int dj = ci - jt;
        if (dj >= 0 && dj <= 8) attn_tile(F.lds, slot, qr, st, dj, iq, cb, 64, F.wave, lane_);
        VM_WAIT(); LDS_WAIT(); __syncthreads();
    }
    attn_store(F, lane_, st, O, qrow, h, 32);
    __syncthreads();
}
__device__ __forceinline__ void attn_sample_unit(Frame& F, const Args& A, int layer, int sb, int h) {
    const bf16* Q = (const bf16*)(F.ws + WS_ACT + A_Q); const bf16* Kb = (const bf16*)(F.ws + WS_ACT + A_K); const bf16* Vb = (const bf16*)(F.ws + WS_ACT + A_V);
    bf16* O = (bf16*)(F.ws + WS_ACT + A_OAB);
    const float* ck = A.in[F_IN_CK] + ((size_t)(layer * DECB + sb) * 512) * 512 + h * 64;
    const float* cv = A.in[F_IN_CV] + ((size_t)(layer * DECB + sb) * 512) * 512 + h * 64;
    int lane_ = F.lane; asm volatile("" : "+v"(lane_));
    const int r32 = lane_ & 31, hi = lane_ >> 5, iq = r32 & 15;
    const size_t qrow = (size_t)MP + sb * 16;
    stage_bias(F, A, layer, h);
    const float cb = LOG2E * A.in[F_IN_RB][((size_t)layer * NH + h) * NREL + 256];
    bf16x8 qr[4];
#pragma unroll
    for (int d0 = 0; d0 < 4; ++d0) qr[d0] = *(const bf16x8*)(Q + (qrow + iq) * 512 + h * 64 + d0 * 16 + hi * 8);
    AttnState st; st.m = -INFINITY; st.l = 0.f; st.o[0] = f32x16{}; st.o[1] = f32x16{};
    f32x4 ka, kb2, va, vb2;
    const int krow = lane_, kcol = F.wave * 8, vrow = 16 * (F.wave & 3) + (lane_ >> 2), vcol = (F.wave >> 2) * 32 + (lane_ & 3) * 8;
#define CACHE_LOAD(jt) do { const float* kp = ck + (size_t)((jt) * 64 + krow) * 512 + kcol; ka = *(const f32x4*)kp; kb2 = *(const f32x4*)(kp + 4); \
                            const float* vp_ = cv + (size_t)((jt) * 64 + vrow) * 512 + vcol; va = *(const f32x4*)vp_; vb2 = *(const f32x4*)(vp_ + 4); } while (0)
#define CACHE_COMMIT(slot) do { v4u w; w.x = cvtpk(ka[0], ka[1]); w.y = cvtpk(ka[2], ka[3]); w.z = cvtpk(kb2[0], kb2[1]); w.w = cvtpk(kb2[2], kb2[3]); \
                                *(LAS v4u*)(F.lds + AT_K + (slot) * AT_SLOT + F.wave * 1024 + lane_ * 16) = w; \
                                w.x = cvtpk(va[0], va[1]); w.y = cvtpk(va[2], va[3]); w.z = cvtpk(vb2[0], vb2[1]); w.w = cvtpk(vb2[2], vb2[3]); \
                                *(LAS v4u*)(F.lds + AT_V + (slot) * AT_SLOT + F.wave * 1024 + lane_ * 16) = w; } while (0)
    CACHE_LOAD(0); CACHE_COMMIT(0);
    LDS_WAIT(); __syncthreads();
    for (int jt = 0; jt <= 8; ++jt) {
        const int slot = jt & 1;
        if (jt < 7) CACHE_LOAD(jt + 1);
        else if (jt == 7) stage_kv_bf16(F.lds, slot ^ 1, Kb, Vb, qrow, 16, h, F.wave, lane_);
        attn_tile(F.lds, slot, qr, st, 8 - jt, iq, cb, jt == 8 ? 16 : 64, F.wave, lane_);
        if (jt < 7) CACHE_COMMIT(slot ^ 1);
        VM_WAIT(); LDS_WAIT(); __syncthreads();
    }
#undef CACHE_LOAD
#undef CACHE_COMMIT
    if (F.wave == 0) attn_store(F, lane_, st, O, qrow, h, 16);
    __syncthreads();
}

constexpr int SP_W = 0, SP_V = 34816, SP_LD = 136;
__device__ __forceinline__ void spatial_unit(Frame& F, const Args& A, int layer, size_t row0, int g, int nvalid, float* bs_out  ) {
    const bf16* UB = (const bf16*)(F.ws + WS_ACT + A_UB); const bf16* VB = (const bf16*)(F.ws + WS_ACT + A_VB); const float* VSS = (const float*)(F.ws + WS_VSS);
    bf16* O = (bf16*)(F.ws + WS_ACT + A_OAB);
    const float* Wsp = A.in[F_IN_WSP] + ((size_t)layer * NG + g) * 128 * 128; const float* bsp = A.in[F_IN_BSP] + ((size_t)layer * NG + g) * 128;
    const float* vg = A.in[F_IN_VG] + (size_t)layer * DB + g * GD;
    LAS bf16* Wt = (LAS bf16*)(F.lds + SP_W); LAS bf16* VT = (LAS bf16*)(F.lds + SP_V);
    int tid_ = F.tid; asm volatile("" : "+v"(tid_)); const int lane_ = tid_ & 63;
    for (int i = tid_; i < 128 * 32; i += NWAVES * 64) { const int t = i >> 5, s0 = (i & 31) * 4; const f32x4 w = *(const f32x4*)(Wsp + t * 128 + s0);
        u32x2 o; o.x = cvtpk(s0 + 0 <= t ? w.x : 0.f, s0 + 1 <= t ? w.y : 0.f); o.y = cvtpk(s0 + 2 <= t ? w.z : 0.f, s0 + 3 <= t ? w.w : 0.f);
        *(LAS u32x2*)(Wt + t * SP_LD + s0) = o; }
    for (int i = tid_; i < 128 * 16; i += NWAVES * 64) { const int s = i >> 4, d0 = (i & 15) * 8;
        float x[8];
        if (s < nvalid) {
            const size_t row = row0 + s;
            const v4u v = *(const v4u*)(VB + row * 512 + g * GD + d0);
            const f32x4 sa = *(const f32x4*)(VSS + row * 8), sb = *(const f32x4*)(VSS + row * 8 + 4);
            const float rstd = __builtin_amdgcn_rsqf(((sa.x + sa.y) + (sa.z + sa.w) + (sb.x + sb.y) + (sb.z + sb.w)) * (1.0f / DB) + EPS);
            const f32x4 g0 = *(const f32x4*)(vg + d0), g1 = *(const f32x4*)(vg + d0 + 4);
            x[0] = bflo(v.x) * rstd * g0.x; x[1] = bfhi(v.x) * rstd * g0.y; x[2] = bflo(v.y) * rstd * g0.z; x[3] = bfhi(v.y) * rstd * g0.w;
            x[4] = bflo(v.z) * rstd * g1.x; x[5] = bfhi(v.z) * rstd * g1.y; x[6] = bflo(v.w) * rstd * g1.z; x[7] = bfhi(v.w) * rstd * g1.w;
            if (bs_out) { float* p = bs_out + (size_t)s * 512 + g * GD + d0; *(f32x4*)p = (f32x4){x[0], x[1], x[2], x[3]}; *(f32x4*)(p + 4) = (f32x4){x[4], x[5], x[6], x[7]}; }
        } else {
#pragma unroll
            for (int e = 0; e < 8; ++e) x[e] = 0.f;
        }
#pragma unroll
        for (int e = 0; e < 8; e += 2) { const unsigned w = cvtpk(x[e], x[e + 1]); VT[(d0 + e) * SP_LD + s] = (bf16)(w & 0xffffu); VT[(d0 + e + 1) * SP_LD + s] = (bf16)(w >> 16); }
    }
    LDS_WAIT(); __syncthreads();
    const int r32 = lane_ & 31, hi = lane_ >> 5, tb = F.wave >> 1, db = F.wave & 1;
    if (tb * 32 < nvalid) {
        f32x16 acc[2]; acc[0] = f32x16{}; acc[1] = f32x16{};
        for (int kk = 0; kk < 2 * (tb + 1); ++kk) {
            const bf16x8 a = *(const LAS bf16x8*)(Wt + (32 * tb + r32) * SP_LD + 16 * kk + 8 * hi);
#pragma unroll
            for (int dt = 0; dt < 2; ++dt) { const bf16x8 bf = *(const LAS bf16x8*)(VT + (64 * db + 32 * dt + r32) * SP_LD + 16 * kk + 8 * hi);
                acc[dt] = __builtin_amdgcn_mfma_f32_32x32x16_bf16(a, bf, acc[dt], 0, 0, 0); }
        }
#pragma unroll
        for (int r = 0; r < 16; ++r) { const int t = 32 * tb + crow(r, hi);
            if (t < nvalid) { const float bt = bsp[t];
#pragma unroll
                for (int dt = 0; dt < 2; ++dt) { const int d = g * GD + 64 * db + 32 * dt + r32;
                    const float ub = __uint_as_float((unsigned)UB[(row0 + t) * 512 + d] << 16);
                    O[(row0 + t) * DM + 512 + d] = (bf16)(cvtpk(ub * (acc[dt][r] + bt), 0.f) & 0xffffu); } } }
    }
    LDS_WAIT(); __syncthreads();
}
__device__ __forceinline__ void mixer_phase(Frame& F, const Args& A, int layer) {
    for (int u = F.vcu; u < NBATCH * NH * 32; u += F.G) { const int cg = 31 - (u >> 4), bh = u & 15; attn_prompt_unit(F, A, layer, bh >> 3, bh & 7, cg * 4); }
    for (int u = F.vcu; u < DECB * NH; u += F.G) attn_sample_unit(F, A, layer, u >> 3, u & 7);
    for (int u = F.vcu; u < (MP / 128) * NG; u += F.G) spatial_unit(F, A, layer, (size_t)(u >> 2) * 128, u & 3, 128, nullptr);
    for (int u = F.vcu; u < DECB * NG; u += F.G) spatial_unit(F, A, layer, (size_t)MP + (u >> 2) * 16, u & 3, 16, F.out + O_BS + (size_t)layer * DECB * DECT * 512 + (size_t)(u >> 2) * DECT * 512);
}

#ifndef MK_PER_PHASE
#define MK_PER_PHASE 0
#endif
constexpr int N_PHASES = 2 + 9 * DEPTH - 1;

__global__ void __launch_bounds__(NWAVES * 64, 2) fwd_kernel(Args args) {
    extern __shared__ __attribute__((aligned(16))) unsigned char lds[];
    Frame F;
    F.lds = (LAS unsigned char*)lds;
    F.MISC = (volatile LAS unsigned*)(F.lds + MISC_OFF);
    F.tid = threadIdx.x; F.lane = F.tid & 63; F.wave = __builtin_amdgcn_readfirstlane(F.tid >> 6);
    F.G = gridDim.x; { const int bx = blockIdx.x; F.vcu = (F.G % 8 == 0) ? (bx % 8) * (F.G / 8) + bx / 8 : bx; }
    F.ws = args.ws; F.out = args.out; F.ctl = (gu32*)(args.ws + WS_CTL);
    for (int u = F.tid; u < (LDS_BYTES - LDSCTL_OFF) / 4; u += NWAVES * 64) ((LAS unsigned*)(F.lds + LDSCTL_OFF))[u] = 0u;
    __syncthreads();
    XcdBarrier bar; bar.bar = (unsigned*)(F.ctl + CW_BAR); bar.x = 0; bar.st = nullptr;
    if (!MK_PER_PHASE) bar = xcd_barrier_post((unsigned*)(F.ctl + CW_BAR), F.MISC + 8);
    const int lo = args.ph_lo, hi = args.ph_hi;
#ifndef ONLY
#define ONLY -1
#endif
#define EN(t) (ONLY < 0 || ONLY == (t))
#define IN(k) (lo <= (k) && (k) < hi)
#define SEAM(k) do { if (IN(k) && IN((k) + 1)) xcd_barrier(bar); } while (0)

    if (EN(0) && IN(0)) { p0_weights(F, args); p0_mod(F, args); } SEAM(0);
    if (EN(1) && IN(1)) { norm_pass(F, args, 0, 0, true); } SEAM(1);
    for (int l = 0; l < DEPTH; ++l) {
        const int pb = 2 + 9 * l;
        unsigned char* wl = F.ws + WS_W + (size_t)l * W_LAYER;
        unsigned char* act = F.ws + WS_ACT;
        const float* MOD = (const float*)(F.ws + WS_MOD) + (size_t)l * NMODB * 6144;
        if (EN(2) && IN(pb + 0)) {
            pg8::Gemm g{(const bf16*)(F.ws + WS_H), (const bf16*)(wl + W_IN), MT, DIN, DM}; pg8::StaticOrder S; S.init(MT, DIN, F.G, (int)blockIdx.x);
            pg8::EpiIn E{act, (float*)(F.ws + WS_VSS), F.out, args.in[F_IN_QG] + l * HD, args.in[F_IN_KG] + l * HD, l};
            pg8::gemm_phase<pg8::EpiIn, pg8::StaticOrder, true, true>(F.lds, g, S, E);
        }
        SEAM(pb + 0);
        if (EN(3) && IN(pb + 1)) { mixer_phase(F, args, l); }
        SEAM(pb + 1);
        if (EN(4) && IN(pb + 2)) {
            pg8::Gemm g{(const bf16*)(act + A_OAB), (const bf16*)(wl + W_AB), MT, DM, DM}; pg8::StaticOrder S; S.init(MT, DM, F.G, (int)blockIdx.x);
            pg8::EpiOutAB E{(const bf16*)(act + A_GR), (const bf16*)(act + A_GB), (bf16*)(act + A_MIX)};
            pg8::gemm_phase<pg8::EpiOutAB, pg8::StaticOrder, true, true>(F.lds, g, S, E);
        }
        SEAM(pb + 2);
        if (EN(5) && IN(pb + 3)) {
            pg8::Gemm g{(const bf16*)(act + A_MIX), (const bf16*)(wl + W_O), MT, DM, DM}; pg8::StaticOrder S; S.init(MT, DM, F.G, (int)blockIdx.x);
            pg8::EpiRes E{l == 0 ? args.in[F_IN_XP] : F.out, l == 0 ? args.in[F_IN_XS] : F.out + (size_t)MP * DM, F.out, MOD + 2 * DM};
            pg8::gemm_phase<pg8::EpiRes, pg8::StaticOrder, true, true>(F.lds, g, S, E);
        }
        SEAM(pb + 3);
        if (EN(6) && IN(pb + 4)) { norm_pass(F, args, l, 1, false); }
        SEAM(pb + 4);
        if (EN(7) && IN(pb + 5)) {
            pg8::Gemm g{(const bf16*)(F.ws + WS_H), (const bf16*)(wl + W_F1), MT, 2 * DFF, DM}; pg8::StaticOrder S; S.init(MT, 2 * DFF, F.G, (int)blockIdx.x);
            pg8::EpiFfnIn E{(bf16*)(act + A_G), (bf16*)(act + A_U), F.out, l};
            pg8::gemm_phase<pg8::EpiFfnIn, pg8::StaticOrder, true, true>(F.lds, g, S, E);
        }
        SEAM(pb + 5);
        if (EN(8) && IN(pb + 6)) { conv_pass(F, args, l); }
        SEAM(pb + 6);
        if (EN(9) && IN(pb + 7)) {
            pg8::Gemm g{(const bf16*)(act + A_U), (const bf16*)(wl + W_F2), MT, DM, DFF}; pg8::StaticOrder S; S.init(MT, DM, F.G, (int)blockIdx.x);
            pg8::EpiRes E{F.out, F.out + (size_t)MP * DM, F.out, MOD + 5 * DM};
            pg8::gemm_phase<pg8::EpiRes, pg8::StaticOrder, true, true>(F.lds, g, S, E);
        }
        if (l + 1 < DEPTH) {
            SEAM(pb + 7);
            if (EN(10) && IN(pb + 8)) { norm_pass(F, args, l + 1, 0, false); }
            SEAM(pb + 8);
        }
    }
#undef IN
#undef SEAM
}

extern "C" void kernel_launch(void* const* d_in, const int* in_sizes, int n_in, void* d_out, int out_size, void* d_ws, size_t ws_size, hipStream_t stream) {
    static int grid = 0;
    if (grid == 0) {
        if (n_in != 25 || in_sizes[0] != MP * DM || out_size != (int)O_END || ws_size < WS_END) {
            fprintf(stderr, "kernel_launch: unexpected problem: n_in %d in0 %d out %d ws %zu (need %zu); nothing launched\n", n_in, n_in > 0 ? in_sizes[0] : -1, out_size, ws_size, (size_t)WS_END); grid = -1; return; }
        int dev = 0, cus = 0, per_cu = 0;
        if (hipGetDevice(&dev) != hipSuccess || hipDeviceGetAttribute(&cus, hipDeviceAttributeMultiprocessorCount, dev) != hipSuccess) { fprintf(stderr, "kernel_launch: device query failed\n"); grid = -1; return; }
        if (hipFuncSetAttribute((const void*)fwd_kernel, hipFuncAttributeMaxDynamicSharedMemorySize, LDS_BYTES) != hipSuccess) { fprintf(stderr, "kernel_launch: hipFuncSetAttribute failed\n"); grid = -1; return; }
        if (hipOccupancyMaxActiveBlocksPerMultiprocessor(&per_cu, (const void*)fwd_kernel, NWAVES * 64, LDS_BYTES) != hipSuccess || per_cu < 1) {
            fprintf(stderr, "kernel_launch: occupancy query reports %d workgroups per CU\n", per_cu); per_cu = 1; }
        (void)hipGetLastError();
        grid = cus;
    }
    if (grid < 0) return;
    if (hipMemsetAsync((char*)d_ws + WS_CTL, 0, CTL_ZERO_BYTES, stream) != hipSuccess) { fprintf(stderr, "kernel_launch: memset failed\n"); return; }
    Args a{};
    for (int i = 0; i < 25; ++i) a.in[i] = (const float*)d_in[i];
    a.out = (float*)d_out; a.ws = (unsigned char*)d_ws;
#if MK_PER_PHASE
    for (int ph = 0; ph < N_PHASES; ++ph) { a.ph_lo = ph; a.ph_hi = ph + 1; hipLaunchKernelGGL(fwd_kernel, dim3(grid), dim3(NWAVES * 64), LDS_BYTES, stream, a); }
#else
    a.ph_lo = 0; a.ph_hi = N_PHASES;
    hipLaunchKernelGGL(fwd_kernel, dim3(grid), dim3(NWAVES * 64), LDS_BYTES, stream, a);
#endif
    const hipError_t le = hipPeekAtLastError();
    if (le != hipSuccess) fprintf(stderr, "kernel_launch: launch failed: %s\n", hipGetErrorName(le));
}
```

```cpp
#include <hip/hip_runtime.h>
#include <cstdio>
#include <cstdint>

constexpr int DM = 1024, NBATCH = 2, SEQ = 8192, DEPTH = 2, DECB = 32, DECT = 16;
constexpr int MP = NBATCH * SEQ, MS = DECB * DECT, MT = MP + MS;
constexpr int NH = 8, HD = 64, DA = 512, DB = 512, NG = 4, GD = 128, DFF = 2816, DIN = 4608, NREL = 257;
constexpr int NMODB = NBATCH + DECB;
constexpr float EPS = 1e-6f;
constexpr float LOG2E = 1.4426950408889634f;
constexpr float QSCALE = 0.125f * LOG2E;
constexpr size_t O_Y = 0, O_KP = (size_t)MT * DM, O_VP = O_KP + (size_t)DEPTH * NBATCH * 512 * 512, O_CP = O_VP + (size_t)DEPTH * NBATCH * 512 * 512,
                 O_KS = O_CP + (size_t)DEPTH * NBATCH * 2 * DFF, O_VS = O_KS + (size_t)DEPTH * DECB * DECT * 512, O_BS = O_VS + (size_t)DEPTH * DECB * DECT * 512,
                 O_CS = O_BS + (size_t)DEPTH * DECB * DECT * 512, O_END = O_CS + (size_t)DEPTH * DECB * 2 * DFF;
static_assert(O_END == 21354496, "output size");

constexpr size_t MiB = 1u << 20;
constexpr size_t WS_CTL = 0, CTL_ZERO_BYTES = 64 * 1024;
constexpr size_t WS_MOD = 1 * MiB;
constexpr size_t WS_VSS = 3 * MiB;
constexpr size_t WS_GS = 4 * MiB;
constexpr size_t WS_CV1 = 5 * MiB;
constexpr size_t WS_CV2 = 7 * MiB;
constexpr size_t WS_SS = 9 * MiB;
constexpr size_t WS_GSI = 10 * MiB + 512 * 1024;
constexpr size_t WS_W = 12 * MiB;
constexpr size_t W_IN = 0, W_AB = (size_t)DIN * DM * 2, W_O = W_AB + (size_t)DM * DM * 2, W_F1 = W_O + (size_t)DM * DM * 2, W_F2 = W_F1 + (size_t)2 * DFF * DM * 2,
                 W_LAYER = W_F2 + (size_t)DM * DFF * 2;
constexpr size_t WS_H = 76 * MiB;
constexpr size_t WS_ACT = 110 * MiB;
constexpr size_t A_Q = 0, A_K = A_Q + (size_t)MT * 512 * 2, A_V = A_K + (size_t)MT * 512 * 2, A_UB = A_V + (size_t)MT * 512 * 2, A_VB = A_UB + (size_t)MT * 512 * 2,
                 A_GR = A_VB + (size_t)MT * 512 * 2, A_GB = A_GR + (size_t)MT * DM * 2, A_OAB = A_GB + (size_t)MT * DM * 2, A_MIX = A_OAB + (size_t)MT * DM * 2,
                 A_END = A_MIX + (size_t)MT * DM * 2;
constexpr size_t A_ACT = 0;
constexpr size_t SIDE_N = (size_t)66 * 2 * DFF;
constexpr size_t A_SIDE = 216 * MiB;
constexpr size_t WS_END = WS_ACT + 240 * MiB;
static_assert(WS_GS + (size_t)DEPTH * 2 * NMODB * DM * 4 <= WS_CV1 && WS_CV1 + (size_t)DEPTH * NMODB * DIN * 4 <= WS_CV2 && WS_CV2 + (size_t)DEPTH * NMODB * 2 * DFF * 4 <= WS_SS && WS_SS + (size_t)MT * 16 * 4 <= WS_GSI && WS_GSI + (size_t)DEPTH * 2 * NMODB * DM * 4 <= WS_W, "small buffers");
static_assert(WS_W + 2 * W_LAYER <= WS_H && WS_H + (size_t)MT * DM * 2 <= WS_ACT && A_END <= A_SIDE && A_ACT + (size_t)MT * DFF * 2 <= A_SIDE && A_SIDE + 3 * 66 * 2 * (size_t)DFF * 4 <= 240 * MiB, "d_ws map");
constexpr int CW_BAR = 1024;

namespace pg8 {
#define PG8_LAS __attribute__((address_space(3)))
typedef unsigned short bf16_t;
typedef short bf16x8 __attribute__((ext_vector_type(8)));
typedef float f32x4 __attribute__((ext_vector_type(4)));
typedef unsigned u32x4 __attribute__((ext_vector_type(4)));
constexpr int BM = 256, BK = 64, HALF = 128, HTB = HALF * BK * 2  , STAGE_BYTES = 8 * HTB, NXCD = 8, WGM = 8;

__host__ __device__ __forceinline__ int lds_byte(int r, int c) { const int st = (r >> 4) * 2 + (c >> 5), rr = r & 15, cc = c & 31, ob = rr * 64 + cc * 2; return st * 1024 + (ob ^ (((ob >> 9) & 1) << 5)); }
__host__ __device__ __forceinline__ void stage_rc(int b, int& R, int& C) { const int st = b / 1024, sb = b % 1024, swz = sb ^ (((sb >> 9) & 1) << 5); R = (st >> 1) * 16 + swz / 64; C = (st & 1) * 32 + (swz % 64) / 2; }
__host__ __device__ __forceinline__ int perm32(int rho) { const int n = rho >> 4, i = rho & 15; return 8 * (i >> 2) + 4 * n + (i & 3); }

struct NoStrip { static constexpr bool ON = false, LATE = false; };
struct NoPre { __device__ __forceinline__ void operator()() const {} };
struct Unit { int pm, pn, ui; };
struct Gemm { const bf16_t* A; const bf16_t* Bt; int M, N, K; };

template <int NM_, int NN_> struct StaticOrderT {
    static constexpr int nM = NM_, nN = NN_, nwg = NM_ * NN_;
    int G, c;
    __host__ __device__ void init(int G_, int c_) { G = G_; c = c_; }
    __host__ __device__ __forceinline__ bool next(int i, Unit& u) const {
        const int L = i * G + c; if (L >= nwg) return false;
        int wgid = L; { constexpr int q = nwg / NXCD, r = nwg % NXCD; const int xcd = wgid % NXCD, off = wgid / NXCD; wgid = (xcd < r ? xcd * (q + 1) : r * (q + 1) + (xcd - r) * q) + off; }
        constexpr int nig = WGM * nN; const int gid = wgid / nig, fm = gid * WGM, gsz = (nM - fm) < WGM ? (nM - fm) : WGM, rem = wgid % nig;
        if (gsz == WGM) { u.pm = fm + (rem % WGM); u.pn = rem / WGM; } else { u.pm = fm + (rem % gsz); u.pn = rem / gsz; }
        u.ui = i; return true;
    }
    __device__ __forceinline__ void a_ready(const Unit&) const {}
    __device__ __forceinline__ void done(const Unit&) const {}
};
template <int NM_, int NN_, int NMP_, int RND_> struct SmpSwapOrderT {
    typedef StaticOrderT<NM_, NN_> Base;
    static constexpr int nM = NM_, nN = NN_, nwg = NM_ * NN_, NSMP = (NM_ - NMP_) * NN_;
    Base b;
    __host__ __device__ void init(int G_, int c_) { b.init(G_, c_); }
    __host__ __device__ __forceinline__ bool next(int i, Unit& u) const {
        if (!b.next(i, u)) return false;
        if (b.G == 256) {
            if (u.pm >= NMP_) { const int s = (u.pm - NMP_) * NN_ + u.pn; Base t; t.init(256, 255 - s); Unit v; v.pm = 0; v.pn = 0; v.ui = 0; t.next(RND_, v); u.pm = v.pm; u.pn = v.pn; }
            else if (i == RND_ && b.c >= 256 - NSMP) { const int s = 255 - b.c; u.pm = NMP_ + s / NN_; u.pn = s % NN_; }
        }
        return true;
    }
    __device__ __forceinline__ void a_ready(const Unit&) const {}
    __device__ __forceinline__ void done(const Unit&) const {}
};


__device__ __forceinline__ unsigned cvt_pk_bf16(float lo, float hi) { unsigned r; asm volatile("v_cvt_pk_bf16_f32 %0, %1, %2" : "=v"(r) : "v"(lo), "v"(hi)); return r; }
__device__ __forceinline__ float bf_lo(unsigned w) { return __uint_as_float(w << 16); }
__device__ __forceinline__ float bf_hi(unsigned w) { return __uint_as_float(w & 0xffff0000u); }
__device__ __forceinline__ float gelu_tanh(float x) {
    const float t = x * (-2.0f * LOG2E * 0.7978845608028654f + (-2.0f * LOG2E * 0.035677408136300125f) * (x * x));
    return x * __builtin_amdgcn_rcpf(1.0f + __builtin_amdgcn_exp2f(t));
}
__device__ __forceinline__ u32x4 pack8(const f32x4 a, const f32x4 b) { u32x4 w; w.x = cvt_pk_bf16(a[0], a[1]); w.y = cvt_pk_bf16(a[2], a[3]); w.z = cvt_pk_bf16(b[0], b[1]); w.w = cvt_pk_bf16(b[2], b[3]); return w; }


__device__ __forceinline__ int row_bidx(int row) { return row < MP ? (row >> 13) : NBATCH + ((row - MP) >> 4); }

struct EpiIn {
    static constexpr bool PERM = true, AFTER_DRAIN = false, MIDK = false;
    unsigned char* act; float* VSS; float* out; const float* qg; const float* kg; const PG8_LAS float* rtab; const PG8_LAS float* ev; const float* cv; int layer;
    __device__ __forceinline__ void operator()(const f32x4 (&acc)[2][2][4][2], const Unit& u, int wr, int wc, int fr, int fq) const {
        const int pn = u.pn, rowt = u.pm * BM + wr * 64 + fr;
        const bool smp = u.pm >= 64;
        const int ca0 = pn * 256 + 32 * wc + 8 * fq, cast = HALF;
        f32x4 cvv[2][2];
        if (!smp) {
#pragma unroll
            for (int bj = 0; bj < 2; ++bj)
#pragma unroll
                for (int n = 0; n < 2; ++n) cvv[bj][n] = *(const PG8_LAS f32x4*)(ev + u.ui * 768 + 32 * wc + 8 * fq + bj * cast + 4 * n);
        }
        const float zsc = pn >= 10 ? -LOG2E : 1.0f;
        if (!smp && pn >= 10) {
#pragma unroll
            for (int bj = 0; bj < 2; ++bj)
#pragma unroll
                for (int n = 0; n < 2; ++n) cvv[bj][n] = cvv[bj][n] * -LOG2E; }
        if (smp) { const float* cp = cv + (size_t)(NBATCH + ((rowt - MP) >> 4)) * DIN + ca0;
#pragma unroll
            for (int bj = 0; bj < 2; ++bj)
#pragma unroll
                for (int n = 0; n < 2; ++n) cvv[bj][n] = *(const f32x4*)(cp + bj * cast + 4 * n); }
        const int which = pn >> 1, half = pn & 1;
        f32x4 gv[2][2];
        if (pn < 4) {
#pragma unroll
            for (int bj = 0; bj < 2; ++bj)
#pragma unroll
                for (int n = 0; n < 2; ++n) gv[bj][n] = *(const f32x4*)((which == 0 ? qg : kg) + 32 * bj + 8 * fq + 4 * n);
        }
        float* fo = nullptr;
        if (pn >= 2 && pn < 6) {
            const int colb = half * 256 + 64 * wc + 8 * fq;
            if (!smp) { if ((u.pm & 31) >= 30) fo = out + O_KP + (size_t)(which - 1) * (O_VP - O_KP) + ((size_t)(layer * NBATCH + (u.pm >> 5)) * 512 + ((u.pm & 31) - 30) * 256 + wr * 64 + fr) * 512 + colb; }
            else fo = out + O_KS + (size_t)(which - 1) * (O_VS - O_KS) + (size_t)layer * (DECB * DECT * 512) + (size_t)((u.pm - 64) * 256 + wr * 64 + fr) * 512 + colb;
        }
#pragma unroll
        for (int ai = 0; ai < 2; ++ai)
#pragma unroll
            for (int m = 0; m < 4; ++m) {
                const size_t roff = (size_t)(ai * HALF + m * 16);
                const size_t row = (size_t)rowt + roff;
                const float rstd = rtab[u.ui * 256 + (int)roff + wr * 64 + fr] * zsc;
                f32x4 v[2][2];
                if (!smp) {
#pragma unroll
                    for (int bj = 0; bj < 2; ++bj)
#pragma unroll
                        for (int n = 0; n < 2; ++n) v[bj][n] = acc[ai][bj][m][n] * rstd + cvv[bj][n];
                } else {
#pragma unroll
                    for (int bj = 0; bj < 2; ++bj)
#pragma unroll
                        for (int n = 0; n < 2; ++n) v[bj][n] = acc[ai][bj][m][n] * rstd + cvv[bj][n] * zsc;
                }
                if (smp && ai * 4 + m + 1 < 8) {
                    const int gn = ai * 4 + m + 1; const float* cp = cv + (size_t)(NBATCH + ((rowt + (gn >> 2) * HALF + (gn & 3) * 16 - MP) >> 4)) * DIN + ca0;
#pragma unroll
                    for (int bj = 0; bj < 2; ++bj)
#pragma unroll
                        for (int n = 0; n < 2; ++n) cvv[bj][n] = *(const f32x4*)(cp + bj * cast + 4 * n); }
                if (pn < 6) {
                    bf16_t* dst = (bf16_t*)(act + A_Q) + (size_t)which * ((size_t)MT * 512);
                    const int colb = half * 256 + 64 * wc + 8 * fq;
                    if (which < 2) {
                        float ss = 0.f;
#pragma unroll
                        for (int bj = 0; bj < 2; ++bj)
#pragma unroll
                            for (int n = 0; n < 2; ++n) ss += (v[bj][n][0] * v[bj][n][0] + v[bj][n][1] * v[bj][n][1]) + (v[bj][n][2] * v[bj][n][2] + v[bj][n][3] * v[bj][n][3]);
                        ss += __shfl_xor(ss, 16); ss += __shfl_xor(ss, 32);
                        const float rs = __builtin_amdgcn_rsqf(ss * (1.0f / 64.0f) + EPS);
#pragma unroll
                        for (int bj = 0; bj < 2; ++bj)
#pragma unroll
                            for (int n = 0; n < 2; ++n) v[bj][n] = v[bj][n] * rs * gv[bj][n];
                    }
                    if (fo) {
#pragma unroll
                        for (int bj = 0; bj < 2; ++bj) { *(f32x4*)(fo + roff * 512 + 32 * bj) = v[bj][0]; *(f32x4*)(fo + roff * 512 + 32 * bj + 4) = v[bj][1]; }
                    }
                    const float sc = which == 0 ? QSCALE : 1.0f;
                    bf16_t* rp = dst + row * 512 + colb;
#pragma unroll
                    for (int bj = 0; bj < 2; ++bj) *(u32x4*)(rp + 32 * bj) = pack8(v[bj][0] * sc, v[bj][1] * sc);
                } else if (pn < 10) {
                    const bool isv = pn >= 8;
                    bf16_t* dst = (bf16_t*)(act + A_UB) + (isv ? (size_t)MT * 512 : 0);
                    const int colb = (pn & 1) * 256 + 64 * wc + 8 * fq;
                    float ss = 0.f;
#pragma unroll
                    for (int bj = 0; bj < 2; ++bj)
#pragma unroll
                        for (int n = 0; n < 2; ++n) {
#pragma unroll
                            for (int e = 0; e < 4; ++e) { const float g = gelu_tanh(v[bj][n][e]); v[bj][n][e] = g; ss += g * g; } }
                    if (isv) { ss += __shfl_xor(ss, 16); ss += __shfl_xor(ss, 32); if (fq == 0) VSS[row * 8 + (pn & 1) * 4 + wc] = ss; }
                    bf16_t* rp = dst + row * 512 + colb;
#pragma unroll
                    for (int bj = 0; bj < 2; ++bj) *(u32x4*)(rp + 32 * bj) = pack8(v[bj][0], v[bj][1]);
                } else {
                    const int ch = 128 * (pn - 10) + 32 * wc + 8 * fq;
                    f32x4 r[2], g[2];
#pragma unroll
                    for (int n = 0; n < 2; ++n)
#pragma unroll
                        for (int e = 0; e < 4; ++e) {
                            const float ea = __builtin_amdgcn_exp2f(fminf(fmaxf(v[0][n][e], -43.f), 43.f)), eb = __builtin_amdgcn_exp2f(fminf(fmaxf(v[1][n][e], -43.f), 43.f));
                            g[n][e] = __builtin_amdgcn_rcpf(1.0f + eb); r[n][e] = (1.0f + eb) * __builtin_amdgcn_rcpf(1.0f + ea);
                        }
                    *(u32x4*)((bf16_t*)(act + A_GR) + row * DM + ch) = pack8(r[0], r[1]);
                    *(u32x4*)((bf16_t*)(act + A_GB) + row * DM + ch) = pack8(g[0], g[1]);
                }
                asm volatile("" ::: "memory");
            }
    }
};

#ifndef OAB_AHEAD
#define OAB_AHEAD 8
#endif
struct EpiOutAB {
    static constexpr bool PERM = true, AFTER_DRAIN = false, MIDK = true;
    const bf16_t *GR, *GB; bf16_t* MIX;
    template <bool FIN> __device__ __forceinline__ void run(f32x4 (&acc)[2][2][4][2], const Unit& u, int wr, int wc, int fr_, int fq_) const {
        int fr = fr_, fq = fq_; asm volatile("" : "+v"(fr), "+v"(fq));
        const int rowt = u.pm * BM + wr * 64 + fr, colb = u.pn * BM + 32 * wc + 8 * fq;
        const bf16_t* G = FIN ? GB : GR;
        constexpr int GA = OAB_AHEAD;
        u32x4 wb[GA][2];
#define OAB_LOAD(B_, G_) do { const bf16_t* rp = G + ((size_t)rowt + ((G_) >> 2) * HALF + ((G_) & 3) * 16) * DM + colb; wb[B_][0] = *(const u32x4*)rp; wb[B_][1] = *(const u32x4*)(rp + HALF); } while (0)
#pragma unroll
        for (int g0 = 0; g0 < GA - 1; ++g0) OAB_LOAD(g0, g0);
#pragma unroll
        for (int g = 0; g < 8; ++g) {
            const int ai = g >> 2, m = g & 3;
            if (g + GA - 1 < 8) OAB_LOAD((g + GA - 1) % GA, g + GA - 1);
            __builtin_amdgcn_sched_barrier(0);
#pragma unroll
            for (int bj = 0; bj < 2; ++bj) { const u32x4 w = wb[g % GA][bj];
                const f32x4 a = acc[ai][bj][m][0] * (f32x4){bf_lo(w.x), bf_hi(w.x), bf_lo(w.y), bf_hi(w.y)};
                const f32x4 b = acc[ai][bj][m][1] * (f32x4){bf_lo(w.z), bf_hi(w.z), bf_lo(w.w), bf_hi(w.w)};
                if (FIN) *(u32x4*)(MIX + ((size_t)rowt + ai * HALF + m * 16) * DM + colb + bj * HALF) = pack8(a, b);
                else { acc[ai][bj][m][0] = a; acc[ai][bj][m][1] = b; } }
            __builtin_amdgcn_sched_barrier(0);
        }
#undef OAB_LOAD
    }
    __device__ __forceinline__ void mid(f32x4 (&acc)[2][2][4][2], const Unit& u, int wr, int wc, int fr, int fq) const { run<false>(acc, u, wr, wc, fr, fq); }
    __device__ __forceinline__ void operator()(const f32x4 (&acc)[2][2][4][2], const Unit& u, int wr, int wc, int fr, int fq) const { run<true>(const_cast<f32x4 (&)[2][2][4][2]>(acc), u, wr, wc, fr, fq); }
};

template <bool SRC_BF16> struct EpiRes {
    static constexpr bool PERM = true, AFTER_DRAIN = false, MIDK = false;
    const float* xin_p; const bf16_t* xbf; const float* gsi; float* xout; const float* gate; const float* gs; bf16_t* XS; float* SS;
    __device__ __forceinline__ void operator()(const f32x4 (&acc)[2][2][4][2], const Unit& u, int wr, int wc, int fr, int fq) const {
        const int rowt = u.pm * BM + wr * 64 + fr, colb = u.pn * BM + 32 * wc + 8 * fq, bidx = u.pm >> 5;
        const float* gp = gate + (size_t)bidx * 6144 + colb;
        f32x4 gt[2][2], gsv[2][2], giv[2][2];
#pragma unroll
        for (int bj = 0; bj < 2; ++bj)
#pragma unroll
            for (int n = 0; n < 2; ++n) { gt[bj][n] = *(const f32x4*)(gp + bj * HALF + 4 * n);
                gsv[bj][n] = gs ? *(const f32x4*)(gs + (size_t)bidx * DM + colb + bj * HALF + 4 * n) : (f32x4){0.f, 0.f, 0.f, 0.f};
                giv[bj][n] = SRC_BF16 ? *(const f32x4*)(gsi + (size_t)bidx * DM + colb + bj * HALF + 4 * n) : (f32x4){0.f, 0.f, 0.f, 0.f}; }
        u32x4 raw[2][SRC_BF16 ? 2 : 4];
#define RES_LOADX(B_, G_) do { const size_t xo = (size_t)(rowt + ((G_) >> 2) * HALF + ((G_) & 3) * 16) * DM + colb; \
        if constexpr (SRC_BF16) { raw[B_][0] = *(const u32x4*)(xbf + xo); raw[B_][1] = *(const u32x4*)(xbf + xo + HALF); } \
        else { _Pragma("unroll") for (int q_ = 0; q_ < 4; ++q_) raw[B_][q_] = *(const u32x4*)(xin_p + xo + (q_ >> 1) * HALF + 4 * (q_ & 1)); } } while (0)
        RES_LOADX(0, 0);
#pragma unroll
        for (int g = 0; g < 8; ++g) {
            const int ai = g >> 2, m = g & 3;
            if (g + 1 < 8) RES_LOADX((g + 1) & 1, g + 1);
            __builtin_amdgcn_sched_barrier(0);
            const int row = rowt + ai * HALF + m * 16;
            const size_t ro = (size_t)row * DM + colb;
            float ss = 0.f;
#pragma unroll
            for (int bj = 0; bj < 2; ++bj) {
                f32x4 xs[2], xn[2];
                if constexpr (SRC_BF16) { const u32x4 w = raw[g & 1][bj];
                    xs[0] = (f32x4){bf_lo(w.x), bf_hi(w.x), bf_lo(w.y), bf_hi(w.y)} * giv[bj][0]; xs[1] = (f32x4){bf_lo(w.z), bf_hi(w.z), bf_lo(w.w), bf_hi(w.w)} * giv[bj][1]; }
                else { xs[0] = __builtin_bit_cast(f32x4, raw[g & 1][bj * 2]); xs[1] = __builtin_bit_cast(f32x4, raw[g & 1][bj * 2 + 1]); }
#pragma unroll
                for (int n = 0; n < 2; ++n) {
                    xn[n] = xs[n] + gt[bj][n] * acc[ai][bj][m][n];
                    if (xout) *(f32x4*)(xout + ro + bj * HALF + 4 * n) = xn[n];
                    ss += (xn[n][0] * xn[n][0] + xn[n][1] * xn[n][1]) + (xn[n][2] * xn[n][2] + xn[n][3] * xn[n][3]);
                }
                if (gs) *(u32x4*)(XS + ro + bj * HALF) = pack8(xn[0] * gsv[bj][0], xn[1] * gsv[bj][1]);
            }
            if (gs) { ss += __shfl_xor(ss, 16); ss += __shfl_xor(ss, 32); if (fq == 0) SS[(size_t)row * 16 + u.pn * 4 + wc] = ss; }
            __builtin_amdgcn_sched_barrier(0);
        }
#undef RES_LOADX
    }
};

__device__ __forceinline__ float dpp_shr1(float old, float src) { return __int_as_float(__builtin_amdgcn_update_dpp(__float_as_int(old), __float_as_int(src), 0x111, 0xf, 0xf, false)); }
__device__ __forceinline__ float dpp_shr2(float old, float src) { return __int_as_float(__builtin_amdgcn_update_dpp(__float_as_int(old), __float_as_int(src), 0x112, 0xf, 0xf, false)); }
__device__ __forceinline__ float conv_taps(float c, float g0, float p, float w1, float w0) {
    asm("s_nop 1\n\tv_fmac_f32_dpp %0, %1, %3 row_shr:1 row_mask:0xf bank_mask:0xf bound_ctrl:1\n\t"
        "v_fmac_f32_dpp %0, %1, %4 row_shr:2 row_mask:0xf bank_mask:0xf bound_ctrl:1\n\t"
        "v_fmac_f32_dpp %0, %2, %3 row_shl:15 row_mask:0xf bank_mask:0xf bound_ctrl:1\n\t"
        "v_fmac_f32_dpp %0, %2, %4 row_shl:14 row_mask:0xf bank_mask:0xf bound_ctrl:1" : "+v"(c) : "v"(g0), "v"(p), "v"(w1), "v"(w0));
    return c;
}
__device__ __forceinline__ float dpp_shr1z(float src) { return __int_as_float(__builtin_amdgcn_update_dpp(0, __float_as_int(src), 0x111, 0xf, 0xf, true)); }
__device__ __forceinline__ float dpp_shr2z(float src) { return __int_as_float(__builtin_amdgcn_update_dpp(0, __float_as_int(src), 0x112, 0xf, 0xf, true)); }
__device__ __forceinline__ float dpp_ror1(float src) { return __int_as_float(__builtin_amdgcn_update_dpp(0, __float_as_int(src), 0x121, 0xf, 0xf, false)); }
__device__ __forceinline__ float dpp_ror2(float src) { return __int_as_float(__builtin_amdgcn_update_dpp(0, __float_as_int(src), 0x122, 0xf, 0xf, false)); }

struct EpiFfnIn {
    static constexpr bool PERM = true, AFTER_DRAIN = false, MIDK = false;
    bf16_t* ACT; float* side; float* out; const float* cw; const float* cb; const float* cc; PG8_LAS float* halo; const PG8_LAS float* rtab; const PG8_LAS float* ev; const float* cv; int layer;
    __device__ __forceinline__ void operator()(const f32x4 (&acc)[2][2][4][2], const Unit& u, int wr, int wc, int fr, int fq) const {
        const bool smp = u.pm >= 64;
        const int rowt = u.pm * BM + wr * 64 + fr, ch = u.pn * HALF + 32 * wc + 8 * fq;
        const int hj = fr >= 14 ? fr - 14 : 0;
        f32x4 cgv[2], cuv[2];
        f32x4 w0[2], w1[2], w2[2], bb[2];
#pragma unroll
        for (int n = 0; n < 2; ++n) { const PG8_LAS float* ep = ev + u.ui * 768 + 256 + 32 * wc + 8 * fq + 4 * n;
            w0[n] = *(const PG8_LAS f32x4*)ep; w1[n] = *(const PG8_LAS f32x4*)(ep + 128); w2[n] = *(const PG8_LAS f32x4*)(ep + 256); bb[n] = *(const PG8_LAS f32x4*)(ep + 384); }
        if (!smp) {
            const PG8_LAS float* cp = ev + u.ui * 768 + 32 * wc + 8 * fq;
            cgv[0] = *(const PG8_LAS f32x4*)cp; cgv[1] = *(const PG8_LAS f32x4*)(cp + 4); cuv[0] = *(const PG8_LAS f32x4*)(cp + HALF); cuv[1] = *(const PG8_LAS f32x4*)(cp + HALF + 4);
            if (fr >= 14) {
#pragma unroll
                for (int ai = 0; ai < 2; ++ai) { const float rs = rtab[u.ui * 256 + ai * HALF + 48 + wr * 64 + fr];
#pragma unroll
                    for (int n = 0; n < 2; ++n) *(PG8_LAS f32x4*)(halo + ((wr * 4 + wc) * 2 + ai) * 64 + hj * 32 + fq * 8 + n * 4) = acc[ai][0][3][n] * rs + cgv[n]; }
            }
        }
        asm volatile("s_waitcnt lgkmcnt(0)" ::: "memory"); __builtin_amdgcn_s_barrier(); asm volatile("" ::: "memory");
        f32x4 pnx[2]; pnx[0] = (f32x4){0.f, 0.f, 0.f, 0.f}; pnx[1] = pnx[0];
#define FFN_SMP_LOAD(ROW_) do { const float* cp_ = cv + (size_t)(NBATCH + (((ROW_) - MP) >> 4)) * (2 * DFF) + u.pn * BM + 32 * wc + 8 * fq; \
            cgv[0] = *(const f32x4*)cp_; cgv[1] = *(const f32x4*)(cp_ + 4); cuv[0] = *(const f32x4*)(cp_ + HALF); cuv[1] = *(const f32x4*)(cp_ + HALF + 4); \
            const float* cq_ = cc + ((size_t)(((ROW_) - MP) >> 4) * 2 + hj) * DFF + ch; pnx[0] = *(const f32x4*)cq_; pnx[1] = *(const f32x4*)(cq_ + 4); } while (0)
        if (smp) FFN_SMP_LOAD(rowt);
#pragma unroll
        for (int ai = 0; ai < 2; ++ai) {
            f32x4 gp[2]; gp[0] = (f32x4){0.f, 0.f, 0.f, 0.f}; gp[1] = gp[0];
#pragma unroll
            for (int m = 0; m < 4; ++m) {
                const int row = rowt + ai * HALF + m * 16;
                const float rs = rtab[u.ui * 256 + ai * HALF + m * 16 + wr * 64 + fr];
                f32x4 gc[2], uf[2];
#pragma unroll
                for (int n = 0; n < 2; ++n) { gc[n] = acc[ai][0][m][n] * rs + cgv[n]; uf[n] = acc[ai][1][m][n] * rs + cuv[n]; }
                f32x4 pv[2]; pv[0] = gp[0]; pv[1] = gp[1];
                if (smp) { pv[0] = pnx[0]; pv[1] = pnx[1];
                    if (ai * 4 + m + 1 < 8) { const int gn = ai * 4 + m + 1, rown = rowt + (gn >> 2) * HALF + (gn & 3) * 16; FFN_SMP_LOAD(rown); } }
                else if (m == 0 && (ai == 1 || wr == 1)) { const PG8_LAS float* hp = halo + (((wr ^ 1) * 4 + wc) * 2 + (wr ? ai : 0)) * 64 + hj * 32 + fq * 8; pv[0] = *(const PG8_LAS f32x4*)hp; pv[1] = *(const PG8_LAS f32x4*)(hp + 4); }
                f32x4 y[2];
#pragma unroll
                for (int n = 0; n < 2; ++n)
#pragma unroll
                    for (int e = 0; e < 4; ++e) {
                        const float g0 = gc[n][e], p = pv[n][e];
                        const float c = conv_taps(__builtin_fmaf(w2[n][e], g0, bb[n][e]), g0, p, w1[n][e], w0[n][e]);
                        y[n][e] = gelu_tanh(c) * uf[n][e];
                    }
                *(u32x4*)(ACT + (size_t)row * DFF + ch) = pack8(y[0], y[1]);
                if (smp) { if (fr >= 14) { float* fo = out + O_CS + ((size_t)(layer * DECB + ((row - MP) >> 4)) * 2 + hj) * DFF + ch; *(f32x4*)fo = gc[0]; *(f32x4*)(fo + 4) = gc[1]; } }
                else {
                    if (ai == 1 && m == 3 && wr == 1 && fr >= 14) { float* gh = side + ((size_t)u.pm * 2 + hj) * DFF + ch; *(f32x4*)gh = gc[0]; *(f32x4*)(gh + 4) = gc[1];
                        if ((u.pm & 31) == 31) { float* fo = out + O_CP + ((size_t)(layer * NBATCH + (u.pm >> 5)) * 2 + hj) * DFF + ch; *(f32x4*)fo = gc[0]; *(f32x4*)(fo + 4) = gc[1]; } }
                    if (ai == 0 && m == 0 && wr == 0 && fr < 2 && (u.pm & 31) != 0) { float* fx = side + SIDE_N + ((size_t)u.pm * 2 + fr) * DFF + ch;
                        *(f32x4*)fx = gc[0]; *(f32x4*)(fx + 4) = gc[1]; *(f32x4*)(fx + SIDE_N) = uf[0]; *(f32x4*)(fx + SIDE_N + 4) = uf[1]; }
                }
                gp[0] = gc[0]; gp[1] = gc[1];
                asm volatile("" ::: "memory");
            }
        }
    }
#undef FFN_SMP_LOAD
};

template <class Epi, class Sched, bool ALIGN_EPI = false, bool SP2 = false, class Strip = NoStrip, class Pre = NoPre, bool ASMDMA = false, bool DMA_FIRST = false>
__device__ __forceinline__ void gemm_phase(PG8_LAS unsigned char* lds, const Gemm g, const Sched& S, const Epi& E, const Strip& Z = Strip(), const Pre& pre = Pre()) {
    static_assert(!Strip::ON || (SP2 && Epi::PERM), "the strip rides on the SP2 schedule");
    int tid_o = threadIdx.x; asm volatile("" : "+v"(tid_o));
    const int tid = tid_o, wid = __builtin_amdgcn_readfirstlane(tid >> 6), lane = tid & 63, wr = wid >> 2, wc = wid & 3, fr = lane & 15, fq = lane >> 4;
    const int K = g.K, nt = K / BK;
    unsigned voffA[2], voffB[2];
#pragma unroll
    for (int i = 0; i < 2; ++i) { int R, C; stage_rc(tid * 16 + i * 8192, R, C); const int Rb = Epi::PERM ? ((R & ~31) + perm32(R & 31)) : R;
        voffA[i] = (unsigned)(R * K + C) * 2u; voffB[i] = (unsigned)(Rb * K + C) * 2u; }
    const unsigned ldsb = (unsigned)(uintptr_t)lds;
    const size_t kstep = (size_t)(BK * 2);
    const size_t hstep = (size_t)HALF * K * 2;
    const size_t tstep = 2 * hstep;
    const unsigned ldsw = (unsigned)wid * 1024u;
    const int aoff = lds_byte(wr * 64 + fr, fq * 8), boff = lds_byte(wc * 32 + fr, fq * 8);
#define PG8_SA(b, h) (((b) * 2 + (h)) * HTB)
#define PG8_SB(b, h) ((4 + (b) * 2 + (h)) * HTB)
#define PG8_STAGE(bufoff, gbase, voff) do { _Pragma("unroll") for (int _i = 0; _i < 2; ++_i) \
        { if constexpr (ASMDMA) { asm volatile("s_mov_b32 m0, %2\n\ts_nop 0\n\tglobal_load_lds_dwordx4 %0, %1" :: "v"((voff)[_i]), "s"((const char*)(gbase)), "s"(ldsb + (unsigned)(bufoff) + ldsw + (unsigned)_i * 8192u) : "memory", "m0"); } else __builtin_amdgcn_global_load_lds((const unsigned*)((const char*)(gbase) + (voff)[_i]), (PG8_LAS unsigned*)(lds + (bufoff) + ldsw + _i * 8192), 16, 0, 0); } } while (0)
#define PG8_LDA(dst, b, h) do { _Pragma("unroll") for (int m = 0; m < 4; ++m) _Pragma("unroll") for (int k = 0; k < 2; ++k) dst[m][k] = *(const PG8_LAS bf16x8*)(lds + PG8_SA(b, h) + aoff + m * 2048 + k * 1024); } while (0)
#define PG8_LDB(dst, b, h) do { _Pragma("unroll") for (int n = 0; n < 2; ++n) _Pragma("unroll") for (int k = 0; k < 2; ++k) dst[n][k] = *(const PG8_LAS bf16x8*)(lds + PG8_SB(b, h) + boff + n * 2048 + k * 1024); } while (0)
#ifndef PG8_PRIO
#define PG8_PRIO 1
#endif
#define PG8_MMA(ai, bj, At, Bt) do { __builtin_amdgcn_s_setprio(PG8_PRIO); _Pragma("unroll") for (int m = 0; m < 4; ++m) _Pragma("unroll") for (int n = 0; n < 2; ++n) _Pragma("unroll") for (int k = 0; k < 2; ++k) \
        acc[ai][bj][m][n] = __builtin_amdgcn_mfma_f32_16x16x32_bf16(Bt[n][k], At[m][k], acc[ai][bj][m][n], 0, 0, 0); __builtin_amdgcn_s_setprio(0); } while (0)
#define PG8_WAIT_V(n) asm volatile("s_waitcnt vmcnt(" #n ")" ::: "memory")
#define PG8_WAIT_VS(n, ns) do { if constexpr (Strip::ON) PG8_WAIT_V(ns); else PG8_WAIT_V(n); } while (0)
    const unsigned zoff = Strip::ON ? ((unsigned)((2 * wid + ((lane >> 3) & 1)) * K) + (unsigned)(((lane & 7) ^ wid) * 8)) * 2u : 0u;
    const int zrd0 = (fr * 8 + (fq ^ (fr >> 1))) * 16, zrd1 = (fr * 8 + ((4 + fq) ^ (fr >> 1))) * 16;
#define PG8_ZSTAGE(b, gz) do { if constexpr (Strip::ON) { if (lane < 16) __builtin_amdgcn_global_load_lds((const unsigned*)((gz) + zoff), (PG8_LAS unsigned*)(lds + STAGE_BYTES + (b) * 2048 + wid * 256), 16, 0, 0); } } while (0)
#define PG8_LDZ(b) do { if constexpr (Strip::ON) { Ax[0] = *(const PG8_LAS bf16x8*)(lds + STAGE_BYTES + (b) * 2048 + zrd0); Ax[1] = *(const PG8_LAS bf16x8*)(lds + STAGE_BYTES + (b) * 2048 + zrd1); } } while (0)
#define PG8_ZMMA() do { if constexpr (Strip::ON) { _Pragma("unroll") for (int k = 0; k < 2; ++k) { const bf16x8 bs = zh ? (wr ? B1[1][k] : B1[0][k]) : (wr ? B0[1][k] : B0[0][k]); \
        accx = __builtin_amdgcn_mfma_f32_16x16x32_bf16(bs, Ax[k], accx, 0, 0, 0); } } } while (0)
#define PG8_WAIT_L(n) asm volatile("s_waitcnt lgkmcnt(" #n ")" ::: "memory")
#define PG8_BAR __builtin_amdgcn_s_barrier()
#define PG8_SCHED __builtin_amdgcn_sched_barrier(0)
    Unit cur, nxt; int ui = 0;
    if (!S.next(0, cur)) return;
    f32x4 acc[2][2][4][2];
#pragma unroll
    for (int a = 0; a < 2; ++a)
#pragma unroll
        for (int b = 0; b < 2; ++b)
#pragma unroll
            for (int m = 0; m < 4; ++m)
#pragma unroll
                for (int n = 0; n < 2; ++n) acc[a][b][m][n] = (f32x4){0.f, 0.f, 0.f, 0.f};
    bf16x8 At[4][2], B0[2][2], B1[2][2];
    f32x4 accx = (f32x4){0.f, 0.f, 0.f, 0.f}; bf16x8 Ax[2]; (void)Ax; (void)accx;
    const size_t zstep = (size_t)16 * K * 2;
    const char* cZ = nullptr; bool zh = false; (void)zh;
    if constexpr (Strip::ON) { cZ = (const char*)Z.zA + (size_t)(cur.pm >> 1) * zstep; zh = (cur.pm & 1) != 0; }
    const char* cA = (const char*)g.A + (size_t)cur.pm * tstep; const char* cB = (const char*)g.Bt + (size_t)cur.pn * tstep;
    S.a_ready(cur);
    if constexpr (SP2) {
        PG8_STAGE(PG8_SB(0, 0), cB, voffB); PG8_STAGE(PG8_SB(0, 1), cB + hstep, voffB); PG8_STAGE(PG8_SA(0, 0), cA, voffA); PG8_STAGE(PG8_SA(0, 1), cA + hstep, voffA); PG8_ZSTAGE(0, cZ);
        pre();
        if (wr == 1) PG8_BAR;
        PG8_WAIT_VS(2, 3); PG8_BAR;
        PG8_STAGE(PG8_SB(1, 0), cB + kstep, voffB); PG8_STAGE(PG8_SA(1, 0), cA + kstep, voffA); PG8_STAGE(PG8_SB(1, 1), cB + hstep + kstep, voffB);
        PG8_WAIT_V(6); PG8_BAR;
    } else {
        PG8_STAGE(PG8_SB(0, 0), cB, voffB); PG8_STAGE(PG8_SA(0, 0), cA, voffA); PG8_STAGE(PG8_SB(0, 1), cB + hstep, voffB); PG8_STAGE(PG8_SA(0, 1), cA + hstep, voffA);
        if (wr == 1) PG8_BAR;
        PG8_WAIT_V(4); PG8_BAR;
        PG8_STAGE(PG8_SB(1, 0), cB + kstep, voffB); PG8_STAGE(PG8_SA(1, 0), cA + kstep, voffA); PG8_STAGE(PG8_SB(1, 1), cB + hstep + kstep, voffB);
        PG8_WAIT_V(6); PG8_BAR;
    }
    for (;;) {
        const bool has_next = S.next(ui + 1, nxt);
        const char* nA = has_next ? (const char*)g.A + (size_t)nxt.pm * tstep : cA; const char* nB = has_next ? (const char*)g.Bt + (size_t)nxt.pn * tstep : cB;
        const char* nZ = cZ; if constexpr (Strip::ON) { if (has_next) nZ = (const char*)Z.zA + (size_t)(nxt.pm >> 1) * zstep; }
        for (int t = 0; t < nt; t += 2) {
            const bool last = (t == nt - 2);
            const char* a1 = cA + (size_t)(t + 1) * kstep;
            const char* a2 = last ? nA : cA + (size_t)(t + 2) * kstep; const char* b2 = last ? nB : cB + (size_t)(t + 2) * kstep;
            const char* a3 = a2 + kstep; const char* b3 = b2 + kstep;
            if (last && has_next) S.a_ready(nxt);
            if constexpr (Epi::MIDK) { if (t == (nt >> 1)) { if constexpr (Strip::ON) { const auto zg = Z.mid_load(cur, wr, wc, fr, fq); E.mid(acc, cur, wr, wc, fr, fq); Z.mid_apply(accx, zg); } else E.mid(acc, cur, wr, wc, fr, fq); } }
            const char* z1 = cZ + (size_t)(t + 1) * kstep; const char* z2 = last ? nZ : cZ + (size_t)(t + 2) * kstep; (void)z1; (void)z2;
            if constexpr (SP2) {
            if constexpr (DMA_FIRST) { PG8_STAGE(PG8_SA(1, 1), a1 + hstep, voffA); PG8_ZSTAGE(1, z1); PG8_SCHED; PG8_LDB(B0, 0, 0); PG8_LDB(B1, 0, 1); PG8_SCHED; PG8_LDA(At, 0, 0); } else {
            PG8_LDB(B0, 0, 0); PG8_LDB(B1, 0, 1); PG8_SCHED; PG8_LDA(At, 0, 0); PG8_STAGE(PG8_SA(1, 1), a1 + hstep, voffA); PG8_ZSTAGE(1, z1); }
            PG8_WAIT_VS(8, 9); PG8_WAIT_L(0); PG8_BAR; PG8_MMA(0, 0, At, B0); PG8_MMA(0, 1, At, B1); PG8_BAR; PG8_SCHED;
            if constexpr (DMA_FIRST) { PG8_STAGE(PG8_SB(0, 0), b2, voffB); PG8_STAGE(PG8_SB(0, 1), b2 + hstep, voffB); PG8_STAGE(PG8_SA(0, 0), a2, voffA); PG8_SCHED; PG8_LDA(At, 0, 1); PG8_LDZ(0); } else {
            PG8_LDA(At, 0, 1); PG8_LDZ(0); PG8_STAGE(PG8_SB(0, 0), b2, voffB); PG8_STAGE(PG8_SB(0, 1), b2 + hstep, voffB); PG8_STAGE(PG8_SA(0, 0), a2, voffA); }
            PG8_WAIT_VS(8, 9); PG8_WAIT_L(0); PG8_BAR; PG8_MMA(1, 0, At, B0); PG8_MMA(1, 1, At, B1); PG8_ZMMA(); PG8_BAR; PG8_SCHED;
            if constexpr (DMA_FIRST) { PG8_STAGE(PG8_SA(0, 1), a2 + hstep, voffA); PG8_ZSTAGE(0, z2); PG8_SCHED; PG8_LDB(B0, 1, 0); PG8_LDB(B1, 1, 1); PG8_SCHED; PG8_LDA(At, 1, 0); } else {
            PG8_LDB(B0, 1, 0); PG8_LDB(B1, 1, 1); PG8_SCHED; PG8_LDA(At, 1, 0); PG8_STAGE(PG8_SA(0, 1), a2 + hstep, voffA); PG8_ZSTAGE(0, z2); }
            PG8_WAIT_VS(8, 9); PG8_WAIT_L(0); PG8_BAR; PG8_MMA(0, 0, At, B0); PG8_MMA(0, 1, At, B1); PG8_BAR; PG8_SCHED;
            if constexpr (DMA_FIRST) { PG8_STAGE(PG8_SB(1, 0), b3, voffB); PG8_STAGE(PG8_SB(1, 1), b3 + hstep, voffB); PG8_STAGE(PG8_SA(1, 0), a3, voffA); PG8_SCHED; PG8_LDA(At, 1, 1); PG8_LDZ(1); } else {
            PG8_LDA(At, 1, 1); PG8_LDZ(1); PG8_STAGE(PG8_SB(1, 0), b3, voffB); PG8_STAGE(PG8_SB(1, 1), b3 + hstep, voffB); PG8_STAGE(PG8_SA(1, 0), a3, voffA); }
            PG8_WAIT_VS(8, 9); PG8_WAIT_L(0); PG8_BAR; PG8_MMA(1, 0, At, B0); PG8_MMA(1, 1, At, B1); PG8_ZMMA(); PG8_BAR; PG8_SCHED;
            } else {
            PG8_LDB(B0, 0, 0); PG8_SCHED; PG8_LDA(At, 0, 0); PG8_STAGE(PG8_SA(1, 1), a1 + hstep, voffA);
            PG8_WAIT_L(8); PG8_BAR; PG8_WAIT_L(0); PG8_MMA(0, 0, At, B0); PG8_BAR; PG8_SCHED;
            PG8_LDB(B1, 0, 1); PG8_STAGE(PG8_SB(0, 0), b2, voffB);
            PG8_BAR; PG8_WAIT_L(0); PG8_MMA(0, 1, At, B1); PG8_BAR;
            PG8_LDA(At, 0, 1); PG8_STAGE(PG8_SA(0, 0), a2, voffA);
            PG8_BAR; PG8_WAIT_L(0); PG8_MMA(1, 0, At, B0); PG8_BAR; PG8_SCHED;
            PG8_STAGE(PG8_SB(0, 1), b2 + hstep, voffB);
            PG8_WAIT_V(6); PG8_BAR; PG8_MMA(1, 1, At, B1); PG8_BAR;
            PG8_LDB(B0, 1, 0); PG8_SCHED; PG8_LDA(At, 1, 0); PG8_STAGE(PG8_SA(0, 1), a2 + hstep, voffA);
            PG8_WAIT_L(8); PG8_BAR; PG8_WAIT_L(0); PG8_MMA(0, 0, At, B0); PG8_BAR; PG8_SCHED;
            PG8_LDB(B1, 1, 1); PG8_STAGE(PG8_SB(1, 0), b3, voffB);
            PG8_BAR; PG8_WAIT_L(0); PG8_MMA(0, 1, At, B1); PG8_BAR;
            PG8_LDA(At, 1, 1); PG8_STAGE(PG8_SA(1, 0), a3, voffA);
            PG8_BAR; PG8_WAIT_L(0); PG8_MMA(1, 0, At, B0); PG8_BAR; PG8_SCHED;
            PG8_STAGE(PG8_SB(1, 1), b3 + hstep, voffB);
            PG8_WAIT_V(6); PG8_BAR; PG8_MMA(1, 1, At, B1); PG8_BAR;
            }
        }
        if constexpr (ALIGN_EPI) { if (wr == 0) PG8_BAR; }
        if constexpr (Strip::ON && !Strip::LATE) { Z.fin(accx, cur, wr, wc, fr, fq, lds + STAGE_BYTES + 4096, wid); accx = (f32x4){0.f, 0.f, 0.f, 0.f}; }
        if constexpr (Strip::ON && Strip::LATE) { const auto zf = Z.fin_load(cur, wr, wc, fr, fq); if constexpr (!Epi::AFTER_DRAIN) { E(acc, cur, wr, wc, fr, fq); S.done(cur); } Z.fin_apply(accx, zf, cur, wr, wc, fr, fq, lds + STAGE_BYTES + 4096, wid); accx = (f32x4){0.f, 0.f, 0.f, 0.f}; }
        else if constexpr (!Epi::AFTER_DRAIN) { E(acc, cur, wr, wc, fr, fq); S.done(cur); }
        if constexpr (Strip::ON) Z.post(cur, fr, fq, lds + STAGE_BYTES + 4096, wid);
        if (!has_next) break;
#pragma unroll
        for (int a = 0; a < 2; ++a)
#pragma unroll
            for (int b = 0; b < 2; ++b)
#pragma unroll
                for (int m = 0; m < 4; ++m)
#pragma unroll
                    for (int n = 0; n < 2; ++n) acc[a][b][m][n] = (f32x4){0.f, 0.f, 0.f, 0.f};
        cur = nxt; cA = nA; cB = nB; ++ui; if constexpr (Strip::ON) { cZ = nZ; zh = (cur.pm & 1) != 0; }
        if constexpr (ALIGN_EPI) { if (wr == 1) PG8_BAR; }
    }
    PG8_WAIT_V(0);
    if constexpr (!ALIGN_EPI) { if (wr == 0) PG8_BAR; }
    PG8_BAR;
    if constexpr (Epi::AFTER_DRAIN) { E.fused(acc, cur, wr, wc, fr, fq, lds, wid, lane); S.done(cur); }
#undef PG8_SA
#undef PG8_SB
#undef PG8_STAGE
#undef PG8_LDA
#undef PG8_LDB
#undef PG8_MMA
#undef PG8_WAIT_V
#undef PG8_WAIT_VS
#undef PG8_ZSTAGE
#undef PG8_LDZ
#undef PG8_ZMMA
#undef PG8_WAIT_L
#undef PG8_BAR
#undef PG8_SCHED
}
}
#define GAS __attribute__((address_space(1)))
#define LAS __attribute__((address_space(3)))
typedef unsigned short bf16;
typedef unsigned v4u __attribute__((ext_vector_type(4)));
typedef float f32x4 __attribute__((ext_vector_type(4)));
typedef short bf16x8 __attribute__((ext_vector_type(8)));
typedef GAS unsigned gu32;
typedef GAS unsigned long long gu64;
#define RLX_AGENT __ATOMIC_RELAXED, __HIP_MEMORY_SCOPE_AGENT
#define LDS_WAIT() asm volatile("s_waitcnt lgkmcnt(0)" ::: "memory")
#define VM_WAIT() asm volatile("s_waitcnt vmcnt(0)" ::: "memory")
__device__ __forceinline__ unsigned long long rt() { return __builtin_amdgcn_s_memrealtime(); }
__device__ __forceinline__ unsigned f2bf(float f) { unsigned u = __builtin_bit_cast(unsigned, f); return (u + 0x7fffu + ((u >> 16) & 1u)) >> 16; }
__device__ __forceinline__ unsigned pk2(float lo, float hi) { return f2bf(lo) | (f2bf(hi) << 16); }

#define XB_TMO      128
#define XB_XCNT(j)  (256  + 64 * (j))
#define XB_XSUB(j)  (1280 + 64 * (j))
#define XB_XGEN(j)  (2304 + 64 * (j))
#define XB_TOP      3328
#define XB_TOPGEN   3392
#define XCD_BAR_WORDS 3456
#define XB_SPIN_CAP (1u << 18)

__device__ __forceinline__ unsigned xb_ld(unsigned* p)              { return __hip_atomic_load(p, __ATOMIC_RELAXED, __HIP_MEMORY_SCOPE_AGENT); }
__device__ __forceinline__ unsigned xb_add(unsigned* p, unsigned v) { return __hip_atomic_fetch_add(p, v, __ATOMIC_RELAXED, __HIP_MEMORY_SCOPE_AGENT); }
__device__ __forceinline__ unsigned xb_xcc_id() { return (unsigned)__builtin_amdgcn_s_getreg((3 << 11) | 20) & 0xFu; }
#define XB_SPIN(cond, bar) do { unsigned _sp = 0; while (cond) { __builtin_amdgcn_s_sleep(1); \
    if ((++_sp & 255u) == 0u) { if (xb_ld(&(bar)[XB_TMO])) break; if (_sp > XB_SPIN_CAP) { atomicAdd(&(bar)[XB_TMO], 1u); break; } } } } while (0)

struct XcdBarrier {
    unsigned* bar; unsigned x;
    volatile LAS unsigned* st;
};

__device__ __forceinline__ XcdBarrier xcd_barrier_post(unsigned* bar, volatile LAS unsigned* st) {
    XcdBarrier b; b.bar = bar; b.x = xb_xcc_id(); b.st = st;
    if (threadIdx.x == 0) (void)xb_add(&bar[XB_XCNT(b.x)], 1u);
    return b;
}
__device__ __forceinline__ void xcd_barrier_complete(unsigned* bar, unsigned x, unsigned& nloc, unsigned& nx) {
    const unsigned G = gridDim.x * gridDim.y * gridDim.z;
    unsigned sum, cnt, mine, sp = 0u;
    for (;;) {
        sum = 0u; cnt = 0u; mine = 0u;
        unsigned cv[16];
#pragma unroll
        for (unsigned j = 0; j < 16; ++j) asm volatile("global_load_dword %0, %1, off sc1" : "=v"(cv[j]) : "v"(&bar[XB_XCNT(j)]) : "memory");
        asm volatile("s_waitcnt vmcnt(0)" ::: "memory");
#pragma unroll
        for (unsigned j = 0; j < 16; ++j) { unsigned c = cv[j]; asm volatile("" : "+v"(c)); sum += c; cnt += (c > 0u) ? 1u : 0u; mine = (j == x) ? c : mine; }
        if (sum == G) break;
        __builtin_amdgcn_s_sleep(1);
        if ((++sp & 255u) == 0u) { if (xb_ld(&bar[XB_TMO])) break; if (sp > XB_SPIN_CAP) { atomicAdd(&bar[XB_TMO], 1u); break; } }
    }
    nloc = mine > 0u ? mine : 1u; nx = cnt > 0u ? cnt : 1u;
}

__device__ __forceinline__ void xcd_barrier(const XcdBarrier& b) {
    asm volatile("s_waitcnt vmcnt(0)" ::: "memory");
    __syncthreads();
    if (threadIdx.x == 0) {
        unsigned* bar = b.bar;
        __builtin_amdgcn_s_waitcnt(0);
        unsigned nloc = b.st[0], nx = b.st[1];
        if (nloc == 0u) { xcd_barrier_complete(bar, b.x, nloc, nx); b.st[0] = nloc; b.st[1] = nx; }
        const unsigned old = xb_add(&bar[XB_XSUB(b.x)], 1u);
        const unsigned gen = old / nloc;
        if (old + 1u == (gen + 1u) * nloc) {
            __builtin_amdgcn_fence(__ATOMIC_RELEASE, "agent");
            asm volatile("s_waitcnt vmcnt(0)" ::: "memory");
            const unsigned og = xb_add(&bar[XB_TOP], 1u);
            const unsigned tg = og / nx;
            if (og + 1u == (tg + 1u) * nx) xb_add(&bar[XB_TOPGEN], 1u);
            else XB_SPIN(xb_ld(&bar[XB_TOPGEN]) == tg, bar);
            __builtin_amdgcn_fence(__ATOMIC_ACQUIRE, "agent");
            xb_add(&bar[XB_XGEN(b.x)], 1u);
            asm volatile("s_waitcnt vmcnt(0)" ::: "memory");
        } else {
            XB_SPIN(xb_ld(&bar[XB_XGEN(b.x)]) == gen, bar);
            __builtin_amdgcn_fence(__ATOMIC_ACQUIRE, "agent");
            asm volatile("s_waitcnt vmcnt(0)" ::: "memory");
        }
    }
    __syncthreads();
}

constexpr int NWAVES = 8;
typedef float f32x16 __attribute__((ext_vector_type(16)));
typedef short s16x4 __attribute__((ext_vector_type(4)));
typedef unsigned u32x2 __attribute__((ext_vector_type(2)));

constexpr int RING_BYTES = 131072;
constexpr int LDSCTL_OFF = 159744, MISC_OFF = LDSCTL_OFF + 320;
constexpr int LDS_BYTES = 163840;

struct Args { const float* in[25]; float* out; unsigned char* ws; int ph_lo, ph_hi; };
static_assert(sizeof(Args) == 25 * 8 + 8 + 8 + 8, "Args has no padding");
struct Frame {
    LAS unsigned char* lds;
    volatile LAS unsigned* MISC;
    gu32* ctl;
    int tid, lane, wave, vcu, G;
    float* out; unsigned char* ws;
};
#define F_IN_XP 0
#define F_IN_XS 1
#define F_IN_CK 2
#define F_IN_CV 3
#define F_IN_CC 4
#define F_IN_CP 5
#define F_IN_CSM 6
#define F_IN_N1 7
#define F_IN_N2 8
#define F_IN_WADA 9
#define F_IN_BADA 10
#define F_IN_WIN 11
#define F_IN_QG 12
#define F_IN_KG 13
#define F_IN_RB 14
#define F_IN_VG 15
#define F_IN_WSP 16
#define F_IN_BSP 17
#define F_IN_WOA 18
#define F_IN_WOB 19
#define F_IN_WO 20
#define F_IN_WF1 21
#define F_IN_CW 22
#define F_IN_CB 23
#define F_IN_WF2 24

__device__ __forceinline__ float xadd1(float v) { return v + __shfl_xor(v, 1); }
__device__ __forceinline__ float wave_sum(float v) {
#pragma unroll
    for (int o = 1; o < 64; o <<= 1) v += __shfl_xor(v, o);
    return v;
}
__device__ __forceinline__ unsigned cvtpk(float lo, float hi) { unsigned r; asm volatile("v_cvt_pk_bf16_f32 %0, %1, %2" : "=v"(r) : "v"(lo), "v"(hi)); return r; }
__device__ __forceinline__ float bflo(unsigned w) { return __uint_as_float(w << 16); }
__device__ __forceinline__ float bfhi(unsigned w) { return __uint_as_float(w & 0xffff0000u); }
__device__ __forceinline__ float gelu_t(float x) { const float u = x * (0.7978845608028654f + 0.035677408136300125f * x * x); return x * __builtin_amdgcn_rcpf(1.0f + __builtin_amdgcn_exp2f(-2.0f * LOG2E * u)); }

__device__ __forceinline__ void p0_transpose_item(const float* W, int ldw, int k0, int n0, bf16* WT, int ldk, int koff, int drow, LAS float* scr, int lane) {
    float v[32];
#pragma unroll
    for (int i = 0; i < 32; ++i) v[i] = W[(size_t)(k0 + 2 * i + (lane >> 5)) * ldw + n0 + (lane & 31)];
#pragma unroll
    for (int i = 0; i < 32; ++i) scr[(2 * i + (lane >> 5)) * 33 + (lane & 31)] = v[i];
    LDS_WAIT(); asm volatile("" ::: "memory");
    const int c = lane & 7;
#pragma unroll
    for (int j = 0; j < 4; ++j) { const int n = (lane >> 3) + 8 * j; const LAS float* s = scr + (8 * c) * 33 + n;
        v4u o; o.x = pk2(s[0 * 33], s[1 * 33]); o.y = pk2(s[2 * 33], s[3 * 33]); o.z = pk2(s[4 * 33], s[5 * 33]); o.w = pk2(s[6 * 33], s[7 * 33]);
        *(GAS v4u*)(WT + (size_t)(drow + n) * ldk + koff + k0 + 8 * c) = o; }
    LDS_WAIT(); asm volatile("" ::: "memory");
}
__device__ __forceinline__ int win_drow(int n0) {
    if (n0 < 2560) { const int tile = n0 >> 8, c = n0 & 255; return tile * 256 + 128 * ((c >> 5) & 1) + 32 * (c >> 6); }
    const int r = n0 - 2560, bj = r >> 10, ch = r & 1023; return 2560 + 256 * (ch >> 7) + 128 * bj + (ch & 127);
}
__device__ __forceinline__ int wf1_drow(int n0) { const int bj = n0 >= DFF ? 1 : 0, ch = n0 - bj * DFF; return 256 * (ch >> 7) + 128 * bj + (ch & 127); }

constexpr int CV_I_IN = (DM / 64) * (DIN / 32), CV_I_OA = (DA / 64) * (DM / 32), CV_I_O = (DM / 64) * (DM / 32), CV_I_F1 = (DM / 64) * (2 * DFF / 32), CV_I_F2 = (DFF / 64) * (DM / 32);
constexpr int CV_PER_L = CV_I_IN + 2 * CV_I_OA + CV_I_O + CV_I_F1 + CV_I_F2;
__device__ __forceinline__ void convert_items(Frame& F, const Args& A, int it0, int it1, int widx, int nw) {
    LAS float* scr = (LAS float*)(F.lds + F.wave * 16384);
    int lane_ = F.lane; asm volatile("" : "+v"(lane_));
    constexpr int I_IN = CV_I_IN, I_OA = CV_I_OA, I_OB = CV_I_OA, I_O = CV_I_O, I_F1 = CV_I_F1, PER_L = CV_PER_L;
    for (int it = it0 + widx * NWAVES + F.wave; it < it1; it += nw * NWAVES) {
        const int l = it / PER_L; int r = it % PER_L;
        bf16* wl = (bf16*)(F.ws + WS_W + (size_t)l * W_LAYER);
        if (r < I_IN) { const int nb = DIN / 32, k0 = 64 * (r / nb), n0 = 32 * (r % nb); p0_transpose_item(A.in[F_IN_WIN] + (size_t)l * DM * DIN, DIN, k0, n0, (bf16*)((char*)wl + W_IN), DM, 0, win_drow(n0), scr, lane_); continue; } r -= I_IN;
        if (r < I_OA) { const int nb = DM / 32, k0 = 64 * (r / nb), n0 = 32 * (r % nb); p0_transpose_item(A.in[F_IN_WOA] + (size_t)l * DA * DM, DM, k0, n0, (bf16*)((char*)wl + W_AB), DM, 0, n0, scr, lane_); continue; } r -= I_OA;
        if (r < I_OB) { const int nb = DM / 32, k0 = 64 * (r / nb), n0 = 32 * (r % nb); p0_transpose_item(A.in[F_IN_WOB] + (size_t)l * DB * DM, DM, k0, n0, (bf16*)((char*)wl + W_AB), DM, DA, n0, scr, lane_); continue; } r -= I_OB;
        if (r < I_O) { const int nb = DM / 32, k0 = 64 * (r / nb), n0 = 32 * (r % nb); p0_transpose_item(A.in[F_IN_WO] + (size_t)l * DM * DM, DM, k0, n0, (bf16*)((char*)wl + W_O), DM, 0, n0, scr, lane_); continue; } r -= I_O;
        if (r < I_F1) { const int nb = 2 * DFF / 32, k0 = 64 * (r / nb), n0 = 32 * (r % nb); p0_transpose_item(A.in[F_IN_WF1] + (size_t)l * DM * 2 * DFF, 2 * DFF, k0, n0, (bf16*)((char*)wl + W_F1), DM, 0, wf1_drow(n0), scr, lane_); continue; } r -= I_F1;
        { const int nb = DM / 32, k0 = 64 * (r / nb), n0 = 32 * (r % nb); p0_transpose_item(A.in[F_IN_WF2] + (size_t)l * DFF * DM, DM, k0, n0, (bf16*)((char*)wl + W_F2), DFF, 0, n0, scr, lane_); }
    }
}
constexpr int ST_ROWB = 2064, ST_HALF = NMODB * ST_ROWB;
typedef float f32x2g __attribute__((ext_vector_type(2)));
template <bool SILU, class RowPtr> __device__ __forceinline__ void st_build(Frame& F, const RowPtr& rowptr) {
    int tid_ = F.tid; asm volatile("" : "+v"(tid_));
    __syncthreads();
    f32x2g raw[NMODB];
#pragma unroll
    for (int b = 0; b < NMODB; ++b) raw[b] = *(const f32x2g*)(rowptr(b) + 2 * tid_);
    __builtin_amdgcn_sched_barrier(0);
#pragma unroll
    for (int b = 0; b < NMODB; ++b) {
        float v0 = raw[b].x, v1 = raw[b].y;
        if (SILU) { v0 = v0 * __builtin_amdgcn_rcpf(1.0f + __builtin_amdgcn_exp2f(-LOG2E * v0)); v1 = v1 * __builtin_amdgcn_rcpf(1.0f + __builtin_amdgcn_exp2f(-LOG2E * v1)); }
        const unsigned hi = cvtpk(v0, v1), lo = cvtpk(v0 - bflo(hi), v1 - bfhi(hi));
        *(LAS unsigned*)(F.lds + b * ST_ROWB + tid_ * 4) = hi; *(LAS unsigned*)(F.lds + ST_HALF + b * ST_ROWB + tid_ * 4) = lo; }
    LDS_WAIT(); __syncthreads();
}
__device__ __forceinline__ bf16x8 st_frag(const Frame& F, int hl, int tile, int s, int r, int q) { int row = 16 * tile + r; if (row > NMODB - 1) row = NMODB - 1;
    return *(const LAS bf16x8*)(F.lds + hl * ST_HALF + row * ST_ROWB + 64 * s + 16 * q); }
__device__ __forceinline__ void skinny34_f32_task(Frame& F, const float* W, size_t ldw, const float* bias, float* out, size_t ldo, int j0, int r, int q) {
    const float* Wp = W + j0 + r + (size_t)(8 * q) * ldw;
    f32x4 acc[3]; acc[0] = (f32x4){0.f, 0.f, 0.f, 0.f}; acc[1] = acc[0]; acc[2] = acc[0];
#pragma unroll 1
    for (int s0 = 0; s0 < 32; s0 += 8) {
        float w[8][8];
#pragma unroll
        for (int i = 0; i < 8; ++i)
#pragma unroll
            for (int e = 0; e < 8; ++e) w[i][e] = Wp[(size_t)(32 * (s0 + i) + e) * ldw];
        __builtin_amdgcn_sched_barrier(0);
#pragma unroll
        for (int i = 0; i < 8; ++i) { const int s = s0 + i;
            v4u hi, lo;
            hi.x = cvtpk(w[i][0], w[i][1]); hi.y = cvtpk(w[i][2], w[i][3]); hi.z = cvtpk(w[i][4], w[i][5]); hi.w = cvtpk(w[i][6], w[i][7]);
            lo.x = cvtpk(w[i][0] - bflo(hi.x), w[i][1] - bfhi(hi.x)); lo.y = cvtpk(w[i][2] - bflo(hi.y), w[i][3] - bfhi(hi.y)); lo.z = cvtpk(w[i][4] - bflo(hi.z), w[i][5] - bfhi(hi.z)); lo.w = cvtpk(w[i][6] - bflo(hi.w), w[i][7] - bfhi(hi.w));
            const bf16x8 bh = __builtin_bit_cast(bf16x8, hi), bl = __builtin_bit_cast(bf16x8, lo);
#pragma unroll
            for (int tl = 0; tl < 3; ++tl) { const bf16x8 ah = st_frag(F, 0, tl, s, r, q), al = st_frag(F, 1, tl, s, r, q);
                acc[tl] = __builtin_amdgcn_mfma_f32_16x16x32_bf16(ah, bh, acc[tl], 0, 0, 0);
                acc[tl] = __builtin_amdgcn_mfma_f32_16x16x32_bf16(ah, bl, acc[tl], 0, 0, 0);
                acc[tl] = __builtin_amdgcn_mfma_f32_16x16x32_bf16(al, bh, acc[tl], 0, 0, 0); } }
        __builtin_amdgcn_sched_barrier(0);
    }
    const float bv = bias ? bias[j0 + r] : 0.f;
#pragma unroll
    for (int tl = 0; tl < 3; ++tl)
#pragma unroll
        for (int e = 0; e < 4; ++e) { const int b = 16 * tl + 4 * q + e; if (b < NMODB) out[(size_t)b * ldo + j0 + r] = acc[tl][e] + bv; }
}
__device__ __forceinline__ void p0_mod(Frame& F, const Args& A) {
    float* MOD = (float*)(F.ws + WS_MOD);
    const float* cp = A.in[F_IN_CP]; const float* cs = A.in[F_IN_CSM];
    st_build<true>(F, [=](int b) { return b < NBATCH ? cp + b * DM : cs + (b - NBATCH) * DM; });
    int lane_ = F.lane; asm volatile("" : "+v"(lane_)); const int r = lane_ & 15, q = lane_ >> 4;
    for (int t = F.wave * F.G + F.vcu; t < DEPTH * 384; t += F.G * NWAVES) {
        const int l = t / 384;
        skinny34_f32_task(F, A.in[F_IN_WADA] + (size_t)l * DM * 6144, 6144, A.in[F_IN_BADA] + l * 6144, MOD + (size_t)l * NMODB * 6144, 6144, (t % 384) * 16, r, q);
    }
    __syncthreads();
}
__device__ __forceinline__ void p1_pass(Frame& F, const Args& A) {
    const float* MOD = (const float*)(F.ws + WS_MOD);
    if (F.G == 256) {
        const int grp = F.vcu >> 6, l = grp >> 1, w2 = grp & 1, N = w2 ? 2 * DFF : DIN;
        const float* sh = MOD + (size_t)l * NMODB * 6144 + (w2 ? 3 * DM : 0);
        st_build<false>(F, [=](int b) { return sh + (size_t)b * 6144; });
        int lane_ = F.lane; asm volatile("" : "+v"(lane_)); const int r = lane_ & 15, q = lane_ >> 4;
        const int t = (F.vcu & 63) * NWAVES + F.wave;
        if (t < N / 16) {
            const int n0 = 16 * t; int a0;
            if (!w2) { if (n0 < 2560) { const int tile = n0 >> 8, tc = n0 & 255; a0 = tile * 256 + 64 * ((tc >> 5) & 3) + 32 * (tc >> 7) + (tc & 31); }
                       else { const int tc = (n0 - 2560) & 255, i = (n0 - 2560) >> 8; a0 = 2560 + 1024 * (tc >> 7) + 128 * i + (tc & 127); } }
            else { const int tile = n0 >> 8, tc = n0 & 255; a0 = DFF * (tc >> 7) + 128 * tile + (tc & 127); }
            const float* W = w2 ? A.in[F_IN_WF1] + (size_t)l * DM * 2 * DFF : A.in[F_IN_WIN] + (size_t)l * DM * DIN;
            float* CV = (float*)(F.ws + (w2 ? WS_CV2 : WS_CV1)) + (size_t)l * NMODB * N;
            skinny34_f32_task(F, W + a0 - n0, (size_t)N, nullptr, CV, (size_t)N, n0, r, q);
        }
        __syncthreads();
    }
    { float* GS = (float*)(F.ws + WS_GS); int tid_ = F.tid; asm volatile("" : "+v"(tid_)); const int gt = F.vcu * NWAVES * 64 + tid_;
      for (int i = gt; i < DEPTH * 2 * NMODB * DM; i += F.G * NWAVES * 64) { const int k = i & 1023, b = (i >> 10) % NMODB, w = ((i >> 10) / NMODB) & 1, l = (i >> 10) / (2 * NMODB);
          const float gsv_ = A.in[w ? F_IN_N2 : F_IN_N1][l * DM + k] * (1.0f + MOD[((size_t)l * NMODB + b) * 6144 + (w ? 4 : 1) * DM + k]);
          GS[i] = gsv_; ((float*)(F.ws + WS_GSI))[i] = 1.0f / gsv_; } }
    { int lane_ = F.lane; asm volatile("" : "+v"(lane_));
      const int gw = F.vcu * NWAVES + F.wave, NGW = F.G * NWAVES;
      const float* g = A.in[F_IN_N1]; bf16* XS = (bf16*)(F.ws + WS_H); float* SS = (float*)(F.ws + WS_SS);
      f32x4 gg[4];
#pragma unroll
      for (int j = 0; j < 4; ++j) gg[j] = *((const f32x4*)g + lane_ + 64 * j);
      for (int row0 = gw; row0 < MT; row0 += 2 * NGW) {
          f32x4 v[2][4], s1[2][4]; int rw[2];
#pragma unroll
          for (int t = 0; t < 2; ++t) { int row = row0 + t * NGW; if (row >= MT) row = row0; rw[t] = row;
              const float* xr = row < MP ? A.in[F_IN_XP] + (size_t)row * DM : A.in[F_IN_XS] + (size_t)(row - MP) * DM;
              const int b = row < MP ? row / SEQ : NBATCH + ((row - MP) >> 4);
              const float* scl = MOD + (size_t)b * 6144 + DM;
#pragma unroll
              for (int j = 0; j < 4; ++j) { v[t][j] = *((const f32x4*)xr + lane_ + 64 * j); s1[t][j] = *((const f32x4*)scl + lane_ + 64 * j); } }
          __builtin_amdgcn_sched_barrier(0);
#pragma unroll
          for (int t = 0; t < 2; ++t) { const int row = rw[t]; float ss = 0.f;
#pragma unroll
              for (int j = 0; j < 4; ++j) { const f32x4 x = v[t][j]; ss += (x.x * x.x + x.y * x.y) + (x.z * x.z + x.w * x.w);
                  const f32x4 y = x * gg[j] * (s1[t][j] + 1.0f);
                  u32x2 o; o.x = cvtpk(y.x, y.y); o.y = cvtpk(y.z, y.w);
                  *((u32x2*)(XS + (size_t)row * DM) + lane_ + 64 * j) = o; }
              ss = wave_sum(ss);
              if (lane_ < 16) SS[(size_t)row * 16 + lane_] = lane_ == 0 ? ss : 0.f; }
      } }
}

constexpr int RTAB_OFF = RING_BYTES + 4096, MAXU = 6;
constexpr int EPIV_OFF = RTAB_OFF + MAXU * 1024, EPIV_STRIDE = 768;
static_assert(EPIV_OFF + MAXU * EPIV_STRIDE * 4 <= LDSCTL_OFF, "LDS map");
template <bool FFN, class Sched> __device__ __forceinline__ void phase_prepass(Frame& F, const Sched& S, const float* cv, int ldcv, const float* cw, const float* cb) {
    const float* SS = (const float*)(F.ws + WS_SS); LAS float* tab = (LAS float*)(F.lds + RTAB_OFF); LAS float* ev = (LAS float*)(F.lds + EPIV_OFF);
    int tid_ = F.tid; asm volatile("" : "+v"(tid_));
    const int r = tid_ >> 1;
    f32x4 a[MAXU], b[MAXU]; float c0[MAXU], c1[MAXU]; bool have[MAXU];
#pragma unroll
    for (int i = 0; i < MAXU; ++i) { pg8::Unit u; have[i] = S.next(i, u); c0[i] = 0.f; c1[i] = 0.f;
        if (have[i]) { const f32x4* sp = (const f32x4*)(SS + ((size_t)u.pm * 256 + r) * 16) + (tid_ & 1) * 2; a[i] = sp[0]; b[i] = sp[1];
            if (tid_ < 256 && u.pm < 64) c0[i] = cv[(size_t)(u.pm >> 5) * ldcv + u.pn * 256 + tid_];
            if (FFN) { const int arr = tid_ >> 7, c = tid_ & 127; c1[i] = arr < 3 ? cw[arr * DFF + u.pn * 128 + c] : cb[u.pn * 128 + c]; } }
        else { a[i] = (f32x4){0.f, 0.f, 0.f, 0.f}; b[i] = a[i]; } }
    __builtin_amdgcn_sched_barrier(0);
#pragma unroll
    for (int i = 0; i < MAXU; ++i) { const f32x4 s4 = a[i] + b[i]; float s = (s4[0] + s4[1]) + (s4[2] + s4[3]);
        s = xadd1(s);
        if (have[i]) { if (!(tid_ & 1)) tab[i * 256 + r] = __builtin_amdgcn_rsqf(s * (1.0f / DM) + EPS);
            if (tid_ < 256) ev[i * EPIV_STRIDE + tid_] = c0[i];
            if (FFN) ev[i * EPIV_STRIDE + 256 + tid_] = c1[i]; } }
    LDS_WAIT(); __syncthreads();
}
static_assert(2 * DFF == 11 * NWAVES * 64, "ffn_fixup: 11 elements per thread");
__device__ __forceinline__ void ffn_fixup(Frame& F, const Args& A, int layer, int pm) {
    if ((pm & 31) == 0) return;
    const float* side = (const float*)(F.ws + WS_ACT + A_SIDE); bf16* ACT = (bf16*)(F.ws + WS_ACT + A_ACT);
    const float* cw = A.in[F_IN_CW] + (size_t)layer * 3 * DFF; const float* cb = A.in[F_IN_CB] + (size_t)layer * DFF;
    const float* gh = side + (size_t)(pm - 1) * 2 * DFF; const float* fg = side + SIDE_N + (size_t)pm * 2 * DFF; const float* fu = fg + SIDE_N;
    int tid_ = F.tid; asm volatile("" : "+v"(tid_));
    float gm2[11], gm1[11], g0[11], uu[11], bb[11], w0[11], w1[11], w2[11];
#pragma unroll
    for (int e = 0; e < 11; ++e) { const int i = tid_ + e * (NWAVES * 64), j = i >= DFF ? 1 : 0, ch = i - j * DFF;
        gm2[e] = gh[j * DFF + ch]; gm1[e] = j ? fg[ch] : gh[DFF + ch]; g0[e] = fg[j * DFF + ch]; uu[e] = fu[j * DFF + ch]; bb[e] = cb[ch]; w0[e] = cw[ch]; w1[e] = cw[DFF + ch]; w2[e] = cw[2 * DFF + ch]; }
    __builtin_amdgcn_sched_barrier(0);
#pragma unroll
    for (int e = 0; e < 11; ++e) { const int i = tid_ + e * (NWAVES * 64), j = i >= DFF ? 1 : 0, ch = i - j * DFF;
        const float c = bb[e] + w0[e] * gm2[e] + w1[e] * gm1[e] + w2[e] * g0[e];
        ACT[((size_t)pm * 256 + j) * DFF + ch] = (bf16)(cvtpk(gelu_t(c) * uu[e], 0.f) & 0xffffu); }
}

constexpr int AT_NS = 4, AT_SLOT = 8192, AT_K = 0, AT_V = AT_NS * AT_SLOT, AT_BT = 2 * AT_NS * AT_SLOT, AT_WS = AT_BT + 1024;
__device__ __forceinline__ int crow(int r, int hi) { return (r & 3) + 8 * (r >> 2) + 4 * hi; }
typedef short v4i16_t __attribute__((ext_vector_type(4)));
__device__ __forceinline__ s16x4 vtr(const LAS unsigned char* p) { return __builtin_bit_cast(s16x4, __builtin_amdgcn_ds_read_tr16_b64_v4i16((LAS v4i16_t*)p)); }
__device__ __forceinline__ float swapmax(float m) { auto rr = __builtin_amdgcn_permlane32_swap(__float_as_uint(m), __float_as_uint(m), false, false); return fmaxf(__uint_as_float(rr[0]), __uint_as_float(rr[1])); }
__device__ __forceinline__ float swapsum(float m) { auto rr = __builtin_amdgcn_permlane32_swap(__float_as_uint(m), __float_as_uint(m), false, false); return __uint_as_float(rr[0]) + __uint_as_float(rr[1]); }


constexpr float AT_THR = 8.f;
struct AttnState { float m, l; f32x16 o[2]; f32x16 ci; int first; };
__device__ __forceinline__ void attn_init(AttnState& st, float cb) {
    st.m = 0.f; st.l = 0.f; st.o[0] = f32x16{}; st.o[1] = f32x16{}; st.first = 1;
#pragma unroll
    for (int r = 0; r < 16; ++r) st.ci[r] = cb;
}
#define MX3(a, b, c) fmaxf(fmaxf((a), (b)), (c))
__device__ __forceinline__ void attn_tile(LAS unsigned char* lds, int slot, const bf16x8 (&qr)[4], AttnState& st, int dj, int iq, int nkeys, int wave, int lane) {
    const int r32 = lane & 31, hi = lane >> 5;
    const int kb = (int)(unsigned)(uintptr_t)(lds + AT_K + slot * AT_SLOT) + hi * 1024 + r32 * 16;
    bf16x8 kf[8];
#pragma unroll
    for (int d0 = 0; d0 < 4; ++d0) {
        asm volatile("ds_read_b128 %0, %1 offset:%c2" : "=&v"(kf[2 * d0]) : "v"(kb), "i"(d0 * 2048) : "memory");
        asm volatile("ds_read_b128 %0, %1 offset:%c2" : "=&v"(kf[2 * d0 + 1]) : "v"(kb), "i"(d0 * 2048 + 512) : "memory"); }
    f32x16 p0, p1;
    asm volatile("s_waitcnt lgkmcnt(6)" : "+v"(kf[0]), "+v"(kf[1]) :: "memory");
    p0 = __builtin_amdgcn_mfma_f32_32x32x16_bf16(kf[0], qr[0], st.ci, 0, 0, 0);
    p1 = __builtin_amdgcn_mfma_f32_32x32x16_bf16(kf[1], qr[0], st.ci, 0, 0, 0);
    asm volatile("s_waitcnt lgkmcnt(4)" : "+v"(kf[2]), "+v"(kf[3]) :: "memory");
    p0 = __builtin_amdgcn_mfma_f32_32x32x16_bf16(kf[2], qr[1], p0, 0, 0, 0);
    p1 = __builtin_amdgcn_mfma_f32_32x32x16_bf16(kf[3], qr[1], p1, 0, 0, 0);
    asm volatile("s_waitcnt lgkmcnt(2)" : "+v"(kf[4]), "+v"(kf[5]) :: "memory");
    p0 = __builtin_amdgcn_mfma_f32_32x32x16_bf16(kf[4], qr[2], p0, 0, 0, 0);
    p1 = __builtin_amdgcn_mfma_f32_32x32x16_bf16(kf[5], qr[2], p1, 0, 0, 0);
    asm volatile("s_waitcnt lgkmcnt(0)" : "+v"(kf[6]), "+v"(kf[7]) :: "memory");
    p0 = __builtin_amdgcn_mfma_f32_32x32x16_bf16(kf[6], qr[3], p0, 0, 0, 0);
    p1 = __builtin_amdgcn_mfma_f32_32x32x16_bf16(kf[7], qr[3], p1, 0, 0, 0);
    if (dj < 3) {
        const int ta = (int)(unsigned)(uintptr_t)(lds + AT_BT) + (dj * 64 + iq + 63 - 4 * hi - 59) * 4;
        typedef float f32x2t __attribute__((ext_vector_type(2)));
        f32x2t tq[16];
#define AT_TRD(i_, kv_) do { asm volatile("ds_read2_b32 %0, %1 offset0:%c2 offset1:%c3" : "=&v"(tq[2 * (i_)]) : "v"(ta), "i"(59 - (kv_) - 1), "i"(59 - (kv_)) : "memory"); \
                             asm volatile("ds_read2_b32 %0, %1 offset0:%c2 offset1:%c3" : "=&v"(tq[2 * (i_) + 1]) : "v"(ta), "i"(27 - (kv_) - 1), "i"(27 - (kv_)) : "memory"); } while (0)
        AT_TRD(0, 0); AT_TRD(1, 2); AT_TRD(2, 8); AT_TRD(3, 10); AT_TRD(4, 16); AT_TRD(5, 18); AT_TRD(6, 24); AT_TRD(7, 26);
#undef AT_TRD
        asm volatile("s_waitcnt lgkmcnt(0)" : "+v"(tq[0]), "+v"(tq[1]), "+v"(tq[2]), "+v"(tq[3]), "+v"(tq[4]), "+v"(tq[5]), "+v"(tq[6]), "+v"(tq[7]),
                                              "+v"(tq[8]), "+v"(tq[9]), "+v"(tq[10]), "+v"(tq[11]), "+v"(tq[12]), "+v"(tq[13]), "+v"(tq[14]), "+v"(tq[15]) :: "memory");
#pragma unroll
        for (int i = 0; i < 8; ++i) { p0[2 * i] += tq[2 * i][1]; p0[2 * i + 1] += tq[2 * i][0]; p1[2 * i] += tq[2 * i + 1][1]; p1[2 * i + 1] += tq[2 * i + 1][0]; }
    }
    if (nkeys < 64) {
#pragma unroll
        for (int r = 0; r < 16; ++r) { if (crow(r, hi) >= nkeys) p0[r] = -INFINITY; p1[r] = -INFINITY; }
    }
    float ma = MX3(p0[0], p0[1], p1[0]), mb = MX3(p0[2], p0[3], p1[1]); ma = MX3(ma, p1[2], p1[3]);
#pragma unroll
    for (int r = 4; r < 16; r += 4) { ma = MX3(ma, p0[r], p0[r + 1]); mb = MX3(mb, p0[r + 2], p0[r + 3]); ma = MX3(ma, p1[r], p1[r + 1]); mb = MX3(mb, p1[r + 2], p1[r + 3]); }
    const float mx = swapmax(fmaxf(ma, mb));
    if (st.first || __any(mx > AT_THR)) {
        const float dl = st.first ? mx : fmaxf(mx, 0.f);
        st.m += dl;
#pragma unroll
        for (int r = 0; r < 16; ++r) { p0[r] -= dl; p1[r] -= dl; st.ci[r] -= dl; }
        if (!st.first) {
            const float f = __builtin_amdgcn_exp2f(-dl);
            st.l *= f;
            LAS float* wsf = (LAS float*)(lds + AT_WS) + wave * 64;
            if (hi == 0) wsf[r32] = f;
            LDS_WAIT(); asm volatile("" ::: "memory");
#pragma unroll
            for (int r = 0; r < 16; ++r) { const float a = wsf[crow(r, hi)]; st.o[0][r] *= a; st.o[1][r] *= a; }
        }
        st.first = 0;
    }
    float rs = 0.f;
#pragma unroll
    for (int r = 0; r < 16; ++r) { p0[r] = __builtin_amdgcn_exp2f(p0[r]); p1[r] = __builtin_amdgcn_exp2f(p1[r]); rs += p0[r] + p1[r]; }
    st.l += rs;
    bf16x8 pa[4];
#pragma unroll
    for (int k = 0; k < 4; ++k) {
        v4u w;
        if (k < 2) { w.x = cvtpk(p0[8 * k + 0], p0[8 * k + 1]); w.y = cvtpk(p0[8 * k + 2], p0[8 * k + 3]); w.z = cvtpk(p0[8 * k + 4], p0[8 * k + 5]); w.w = cvtpk(p0[8 * k + 6], p0[8 * k + 7]); }
        else { const int q = k - 2; w.x = cvtpk(p1[8 * q + 0], p1[8 * q + 1]); w.y = cvtpk(p1[8 * q + 2], p1[8 * q + 3]); w.z = cvtpk(p1[8 * q + 4], p1[8 * q + 5]); w.w = cvtpk(p1[8 * q + 6], p1[8 * q + 7]); }
        pa[k] = __builtin_bit_cast(bf16x8, w);
    }
    const int vb = (int)(unsigned)(uintptr_t)(lds + AT_V + slot * AT_SLOT) + ((lane >> 4) & 1) * 32 + (lane & 3) * 8 + (4 * hi + ((lane & 15) >> 2)) * 64;
#pragma unroll
    for (int d0 = 0; d0 < 2; ++d0) { s16x4 lo[4], hh[4];
#pragma unroll
        for (int ks = 0; ks < 4; ++ks) {
            asm volatile("ds_read_b64_tr_b16 %0, %1 offset:%c2" : "=&v"(lo[ks]) : "v"(vb), "i"(d0 * 4096 + ks * 1024) : "memory");
            asm volatile("ds_read_b64_tr_b16 %0, %1 offset:%c2" : "=&v"(hh[ks]) : "v"(vb), "i"(d0 * 4096 + ks * 1024 + 512) : "memory"); }
        asm volatile("s_waitcnt lgkmcnt(0)" ::: "memory"); __builtin_amdgcn_sched_barrier(0);
#pragma unroll
        for (int ks = 0; ks < 4; ++ks) { const bf16x8 vf = (bf16x8){lo[ks][0], lo[ks][1], lo[ks][2], lo[ks][3], hh[ks][0], hh[ks][1], hh[ks][2], hh[ks][3]};
            st.o[d0] = __builtin_amdgcn_mfma_f32_32x32x16_bf16(pa[ks], vf, st.o[d0], 0, 0, 0); }
    }
}
__device__ __forceinline__ void stage_kv_bf16(LAS unsigned char* lds, int slot, const bf16* Kb, const bf16* Vb, size_t row0, int nvalid, int h, int wave, int lane) {
    int kr = lane; if (kr >= nvalid) kr = nvalid - 1;
    __builtin_amdgcn_global_load_lds((const unsigned*)(Kb + (row0 + kr) * 512 + h * 64 + wave * 8), (LAS unsigned*)(lds + AT_K + slot * AT_SLOT + wave * 1024), 16, 0, 0);
    int vr = 16 * (wave & 3) + (lane >> 2); if (vr >= nvalid) vr = nvalid - 1;
    __builtin_amdgcn_global_load_lds((const unsigned*)(Vb + (row0 + vr) * 512 + h * 64 + (wave >> 2) * 32 + (lane & 3) * 8), (LAS unsigned*)(lds + AT_V + slot * AT_SLOT + wave * 1024), 16, 0, 0);
}
__device__ __forceinline__ void stage_bias(Frame& F, const Args& A, int layer, int h) {
    const float* rb = A.in[F_IN_RB] + ((size_t)layer * NH + h) * NREL;
    int tid_ = F.tid; asm volatile("" : "+v"(tid_));
    if (tid_ < 255) { int d = tid_ - 63; if (d > 128) d = 128; ((LAS float*)(F.lds + AT_BT))[tid_] = LOG2E * (rb[d + 128] - rb[256]); }
}
constexpr int AT_OST = AT_WS + 2048;
__device__ __forceinline__ void attn_store(Frame& F, int lane_, const AttnState& st, bf16* O, size_t orow0, int h, int nrows) {
    const int r32 = lane_ & 31, hi = lane_ >> 5;
    const float lt = swapsum(st.l);
    LAS float* wsf = (LAS float*)(F.lds + AT_WS) + F.wave * 64;
    if (hi == 0) wsf[r32] = __builtin_amdgcn_rcpf(lt);
    LDS_WAIT(); asm volatile("" ::: "memory");
    LAS bf16* stg = (LAS bf16*)(F.lds + AT_OST) + F.wave * 2048;
#pragma unroll
    for (int r = 0; r < 16; ++r) { const int q = crow(r, hi); const float a = wsf[q];
#pragma unroll
        for (int d0 = 0; d0 < 2; ++d0) stg[q * 64 + d0 * 32 + r32] = (bf16)(cvtpk(st.o[d0][r] * a, 0.f) & 0xffffu); }
    LDS_WAIT(); asm volatile("" ::: "memory");
#pragma unroll
    for (int i = 0; i < 4; ++i) { const int row = i * 8 + (lane_ >> 3), ch = lane_ & 7;
        if (row < nrows) *(v4u*)(O + (orow0 + row) * DM + h * 64 + ch * 8) = *(const LAS v4u*)(stg + row * 64 + ch * 8); }
    LDS_WAIT(); asm volatile("" ::: "memory");
}
__device__ __forceinline__ void attn_prompt_unit(Frame& F, const Args& A, int layer, int b, int h, int c0) {
    const bf16* Q = (const bf16*)(F.ws + WS_ACT + A_Q); const bf16* Kb = (const bf16*)(F.ws + WS_ACT + A_K); const bf16* Vb = (const bf16*)(F.ws + WS_ACT + A_V);
    bf16* O = (bf16*)(F.ws + WS_ACT + A_OAB);
    int lane_ = F.lane; asm volatile("" : "+v"(lane_));
    const int r32 = lane_ & 31, hi = lane_ >> 5, ci = c0 + (F.wave >> 1), iq = 32 * (F.wave & 1) + r32;
    const size_t qrow = (size_t)b * SEQ + c0 * 64 + F.wave * 32;
    stage_bias(F, A, layer, h);
    const float cb = LOG2E * A.in[F_IN_RB][((size_t)layer * NH + h) * NREL + 256];
    bf16x8 qr[4];
#pragma unroll
    for (int d0 = 0; d0 < 4; ++d0) qr[d0] = *(const bf16x8*)(Q + (qrow + r32) * 512 + h * 64 + d0 * 16 + hi * 8);
    AttnState st; attn_init(st, cb);
    const int jlo = c0 >= 8 ? c0 - 8 : 0, nt = c0 + 4 - jlo;
#pragma unroll
    for (int i = 0; i < 3; ++i) if (i < nt) stage_kv_bf16(F.lds, i, Kb, Vb, (size_t)b * SEQ + (jlo + i) * 64, 64, h, F.wave, lane_);
    LDS_WAIT();
    for (int i = 0; i < nt; ++i) {
        const int rem = nt - 1 - i;
        if (rem >= 2) asm volatile("s_waitcnt vmcnt(4)" ::: "memory"); else if (rem == 1) asm volatile("s_waitcnt vmcnt(2)" ::: "memory"); else asm volatile("s_waitcnt vmcnt(0)" ::: "memory");
        __builtin_amdgcn_s_barrier(); asm volatile("" ::: "memory");
        if (i + 3 < nt) stage_kv_bf16(F.lds, (i + 3) & 3, Kb, Vb, (size_t)b * SEQ + (jlo + i + 3) * 64, 64, h, F.wave, lane_);
        const int dj = ci - (jlo + i);
        if (dj >= 0 && dj <= 8) attn_tile(F.lds, i & 3, qr, st, dj, iq, 64, F.wave, lane_);
    }
    attn_store(F, lane_, st, O, qrow, h, 32);
    __syncthreads();
}
__device__ __forceinline__ void attn_sample_unit(Frame& F, const Args& A, int layer, int sb, int h) {
    const bf16* Q = (const bf16*)(F.ws + WS_ACT + A_Q); const bf16* Kb = (const bf16*)(F.ws + WS_ACT + A_K); const bf16* Vb = (const bf16*)(F.ws + WS_ACT + A_V);
    bf16* O = (bf16*)(F.ws + WS_ACT + A_OAB);
    const float* ck = A.in[F_IN_CK] + ((size_t)(layer * DECB + sb) * 512) * 512 + h * 64;
    const float* cv = A.in[F_IN_CV] + ((size_t)(layer * DECB + sb) * 512) * 512 + h * 64;
    int lane_ = F.lane; asm volatile("" : "+v"(lane_));
    const int r32 = lane_ & 31, hi = lane_ >> 5, iq = r32 & 15;
    const size_t qrow = (size_t)MP + sb * 16;
    stage_bias(F, A, layer, h);
    const float cb = LOG2E * A.in[F_IN_RB][((size_t)layer * NH + h) * NREL + 256];
    bf16x8 qr[4];
#pragma unroll
    for (int d0 = 0; d0 < 4; ++d0) qr[d0] = *(const bf16x8*)(Q + (qrow + iq) * 512 + h * 64 + d0 * 16 + hi * 8);
    AttnState st; attn_init(st, cb);
    int tid_ = F.tid; asm volatile("" : "+v"(tid_));
    const int crw = tid_ >> 3, ccl = (tid_ & 7) * 8;
    const unsigned kdst = AT_K + (ccl >> 3) * 1024 + crw * 16, vdst = AT_V + ((ccl >> 5) * 4 + (crw >> 4)) * 1024 + (crw & 15) * 64 + (ccl & 31) * 2;
    f32x4 ka[2], kb2[2], va[2], vb2[2];
#define CACHE_LOAD(S_, jt) do { const float* kp = ck + (size_t)((jt) * 64 + crw) * 512 + ccl; ka[S_] = *(const f32x4*)kp; kb2[S_] = *(const f32x4*)(kp + 4); \
                                const float* vp_ = cv + (size_t)((jt) * 64 + crw) * 512 + ccl; va[S_] = *(const f32x4*)vp_; vb2[S_] = *(const f32x4*)(vp_ + 4); } while (0)
#define CACHE_COMMIT(S_, slot) do { v4u w; w.x = cvtpk(ka[S_][0], ka[S_][1]); w.y = cvtpk(ka[S_][2], ka[S_][3]); w.z = cvtpk(kb2[S_][0], kb2[S_][1]); w.w = cvtpk(kb2[S_][2], kb2[S_][3]); \
                                *(LAS v4u*)(F.lds + (slot) * AT_SLOT + kdst) = w; \
                                w.x = cvtpk(va[S_][0], va[S_][1]); w.y = cvtpk(va[S_][2], va[S_][3]); w.z = cvtpk(vb2[S_][0], vb2[S_][1]); w.w = cvtpk(vb2[S_][2], vb2[S_][3]); \
                                *(LAS v4u*)(F.lds + (slot) * AT_SLOT + vdst) = w; } while (0)
    CACHE_LOAD(0, 0); CACHE_LOAD(1, 1);
    CACHE_COMMIT(0, 0); CACHE_LOAD(0, 2);
    LDS_WAIT(); __syncthreads();
#define SAMPLE_STEP(S_) do { const int jt = 2 * g2 + (S_), slot = jt & 1; \
        if (jt + 1 <= 7) CACHE_COMMIT(((S_) + 1) & 1, slot ^ 1); \
        if (jt + 3 <= 7) CACHE_LOAD(((S_) + 1) & 1, jt + 3); \
        if (jt == 7) stage_kv_bf16(F.lds, slot ^ 1, Kb, Vb, qrow, 16, h, F.wave, lane_); \
        if (F.wave == 0) attn_tile(F.lds, slot, qr, st, 8 - jt, iq, jt == 8 ? 16 : 64, F.wave, lane_);     \
        if (jt == 7) VM_WAIT(); \
        LDS_WAIT(); __syncthreads(); } while (0)
#pragma unroll 1
    for (int g2 = 0; g2 < 4; ++g2) { SAMPLE_STEP(0); SAMPLE_STEP(1); }
    { const int g2 = 4; SAMPLE_STEP(0); }
#undef SAMPLE_STEP
#undef CACHE_LOAD
#undef CACHE_COMMIT
    if (F.wave == 0) attn_store(F, lane_, st, O, qrow, h, 16);
    __syncthreads();
}

constexpr int SP_W = 0, SP_LD = 136, SP_V = 34816, SP_M = SP_V + 32768, SP_MLD = 68;
__device__ __forceinline__ void spatial_stage_w(Frame& F, const Args& A, int layer, int g) {
    const float* Wsp = A.in[F_IN_WSP] + ((size_t)layer * NG + g) * 128 * 128;
    LAS bf16* Wt = (LAS bf16*)(F.lds + SP_W);
    int tid_ = F.tid; asm volatile("" : "+v"(tid_));
    f32x4 wv[8];
#pragma unroll
    for (int j = 0; j < 8; ++j) { const int i = tid_ + j * (NWAVES * 64), t = i >> 5, s0 = (i & 31) * 4; wv[j] = *(const f32x4*)(Wsp + t * 128 + s0); }
    __builtin_amdgcn_sched_barrier(0);
#pragma unroll
    for (int j = 0; j < 8; ++j) { const int i = tid_ + j * (NWAVES * 64), t = i >> 5, s0 = (i & 31) * 4; const f32x4 w = wv[j];
        u32x2 o; o.x = cvtpk(s0 + 0 <= t ? w.x : 0.f, s0 + 1 <= t ? w.y : 0.f); o.y = cvtpk(s0 + 2 <= t ? w.z : 0.f, s0 + 3 <= t ? w.w : 0.f);
        *(LAS u32x2*)(Wt + t * SP_LD + s0) = o; }
}
__device__ __forceinline__ void spatial_unit(Frame& F, const Args& A, int layer, size_t row0, int g, int nvalid, float* bs_out  ) {
    const bf16* UB = (const bf16*)(F.ws + WS_ACT + A_UB); const bf16* VB = (const bf16*)(F.ws + WS_ACT + A_VB); const float* VSS = (const float*)(F.ws + WS_VSS);
    bf16* O = (bf16*)(F.ws + WS_ACT + A_OAB);
    const float* bsp = A.in[F_IN_BSP] + ((size_t)layer * NG + g) * 128;
    const float* vg = A.in[F_IN_VG] + (size_t)layer * DB + g * GD;
    int tid_ = F.tid; asm volatile("" : "+v"(tid_)); const int lane_ = tid_ & 63;
    {
        const int nrow = nvalid < 32 ? 32 : nvalid, nit = (nrow * 16 + NWAVES * 64 - 1) / (NWAVES * 64);
        v4u vv[4]; f32x4 sa[4], sb[4];
        const int d0 = (tid_ & 15) * 8;
        const f32x4 g0 = *(const f32x4*)(vg + d0), g1 = *(const f32x4*)(vg + d0 + 4);
#pragma unroll
        for (int it = 0; it < 4; ++it) { const int s = (tid_ >> 4) + it * 32;
            if (it < nit && s < nvalid) { const size_t row = row0 + s; vv[it] = *(const v4u*)(VB + row * 512 + g * GD + d0); sa[it] = *(const f32x4*)(VSS + row * 8); sb[it] = *(const f32x4*)(VSS + row * 8 + 4); }
            else { vv[it] = (v4u){0u, 0u, 0u, 0u}; sa[it] = (f32x4){1.f, 1.f, 1.f, 1.f}; sb[it] = sa[it]; } }
        __builtin_amdgcn_sched_barrier(0);
#pragma unroll
        for (int it = 0; it < 4; ++it) { const int s = (tid_ >> 4) + it * 32;
            if (it < nit) {
                v4u o = {0u, 0u, 0u, 0u};
                if (s < nvalid) {
                    const v4u v = vv[it];
                    const float rstd = __builtin_amdgcn_rsqf(((sa[it].x + sa[it].y) + (sa[it].z + sa[it].w) + (sb[it].x + sb[it].y) + (sb[it].z + sb[it].w)) * (1.0f / DB) + EPS);
                    float x[8];
                    x[0] = bflo(v.x) * rstd * g0.x; x[1] = bfhi(v.x) * rstd * g0.y; x[2] = bflo(v.y) * rstd * g0.z; x[3] = bfhi(v.y) * rstd * g0.w;
                    x[4] = bflo(v.z) * rstd * g1.x; x[5] = bfhi(v.z) * rstd * g1.y; x[6] = bflo(v.w) * rstd * g1.z; x[7] = bfhi(v.w) * rstd * g1.w;
                    if (bs_out) { float* p = bs_out + (size_t)s * 512 + g * GD + d0; *(f32x4*)p = (f32x4){x[0], x[1], x[2], x[3]}; *(f32x4*)(p + 4) = (f32x4){x[4], x[5], x[6], x[7]}; }
                    o.x = cvtpk(x[0], x[1]); o.y = cvtpk(x[2], x[3]); o.z = cvtpk(x[4], x[5]); o.w = cvtpk(x[6], x[7]);
                }
                *(LAS v4u*)(F.lds + SP_V + ((d0 >> 5) * 8 + (s >> 4)) * 1024 + (s & 15) * 64 + (d0 & 31) * 2) = o; } }
    }
    LDS_WAIT(); __syncthreads();
    const int r32 = lane_ & 31, hi = lane_ >> 5, tb = F.wave >> 1, db = F.wave & 1;
    if (tb * 32 < nvalid) {
        f32x16 acc[2]; acc[0] = f32x16{}; acc[1] = f32x16{};
        float btv[16];
#pragma unroll
        for (int r = 0; r < 16; ++r) btv[r] = bsp[32 * tb + crow(r, hi)];
        __builtin_amdgcn_sched_barrier(0);
        const LAS unsigned char* wp = F.lds + SP_W + ((32 * tb + r32) * SP_LD + 4 * hi) * 2;
        const LAS unsigned char* vp = F.lds + SP_V + ((lane_ >> 4) & 1) * 32 + (lane_ & 3) * 8 + (4 * hi + ((lane_ & 15) >> 2)) * 64 + (2 * db) * 8192;
        for (int kk = 0; kk < 2 * (tb + 1); ++kk) {
            const s16x4 a0 = *(const LAS s16x4*)(wp + kk * 32), a1 = *(const LAS s16x4*)(wp + kk * 32 + 16);
            const bf16x8 a = (bf16x8){a0[0], a0[1], a0[2], a0[3], a1[0], a1[1], a1[2], a1[3]};
#pragma unroll
            for (int dt = 0; dt < 2; ++dt) { const s16x4 lo = vtr(vp + dt * 8192 + kk * 1024), hh = vtr(vp + dt * 8192 + kk * 1024 + 512);
                const bf16x8 vf = (bf16x8){lo[0], lo[1], lo[2], lo[3], hh[0], hh[1], hh[2], hh[3]};
                acc[dt] = __builtin_amdgcn_mfma_f32_32x32x16_bf16(a, vf, acc[dt], 0, 0, 0); }
        }
        LAS float* M = (LAS float*)(F.lds + SP_M) + F.wave * 32 * SP_MLD;
#pragma unroll
        for (int r = 0; r < 16; ++r) { const int tl = crow(r, hi); const float bt = btv[r]; M[tl * SP_MLD + r32] = acc[0][r] + bt; M[tl * SP_MLD + 32 + r32] = acc[1][r] + bt; }
        LDS_WAIT(); asm volatile("" ::: "memory");
        v4u ubv[4];
#pragma unroll
        for (int it = 0; it < 4; ++it) { const int j = it * 64 + lane_, tl = j >> 3, d8 = (j & 7) * 8, t = 32 * tb + tl;
            ubv[it] = t < nvalid ? *(const v4u*)(UB + (row0 + t) * 512 + g * GD + 64 * db + d8) : (v4u){0u, 0u, 0u, 0u}; }
        __builtin_amdgcn_sched_barrier(0);
#pragma unroll
        for (int it = 0; it < 4; ++it) { const int j = it * 64 + lane_, tl = j >> 3, d8 = (j & 7) * 8, t = 32 * tb + tl;
            if (t < nvalid) {
                const f32x4 m0 = *(const LAS f32x4*)(M + tl * SP_MLD + d8), m1 = *(const LAS f32x4*)(M + tl * SP_MLD + d8 + 4);
                const v4u ub = ubv[it];
                v4u o; o.x = cvtpk(bflo(ub.x) * m0.x, bfhi(ub.x) * m0.y); o.y = cvtpk(bflo(ub.y) * m0.z, bfhi(ub.y) * m0.w); o.z = cvtpk(bflo(ub.z) * m1.x, bfhi(ub.z) * m1.y); o.w = cvtpk(bflo(ub.w) * m1.z, bfhi(ub.w) * m1.w);
                *(v4u*)(O + (row0 + t) * DM + 512 + g * GD + 64 * db + d8) = o; } }
    }
    LDS_WAIT(); __syncthreads();
}
#ifndef REP_MX
#define REP_MX 0
#endif
#define REPM(k) for (int reps_ = [] { int r = (REP_MX == (k)) ? 2 : 1; asm volatile("" : "+s"(r)); return r; }(), r_ = 0; r_ < reps_; ++r_)
__device__ __forceinline__ void mixer_phase(Frame& F, const Args& A, int layer) {
    REPM(1) { if (F.G == 256) { const int x = F.vcu >> 5, j = F.vcu & 31, bh = 2 * x + (j & 1);
                  for (int k = 0; k < 2; ++k) attn_prompt_unit(F, A, layer, bh >> 3, bh & 7, (31 - ((j >> 1) + 16 * k)) * 4); }
              else for (int u = F.vcu; u < NBATCH * NH * 32; u += F.G) { const int cg = 31 - (u >> 4), bh = u & 15; attn_prompt_unit(F, A, layer, bh >> 3, bh & 7, cg * 4); } }
    REPM(2) for (int u = F.vcu; u < DECB * NH; u += F.G) attn_sample_unit(F, A, layer, u >> 3, u & 7);
    if (F.G % 4 == 0) { __syncthreads(); spatial_stage_w(F, A, layer, F.vcu & 3); }
    REPM(3) for (int u = F.vcu; u < (MP / 128) * NG; u += F.G) spatial_unit(F, A, layer, (size_t)(u >> 2) * 128, u & 3, 128, nullptr);
    REPM(4) for (int u = F.vcu; u < DECB * NG; u += F.G) spatial_unit(F, A, layer, (size_t)MP + (u >> 2) * 16, u & 3, 16, F.out + O_BS + (size_t)layer * DECB * DECT * 512 + (size_t)(u >> 2) * DECT * 512);
}
struct MiniOutAB {
    static constexpr bool MIDK = true, POST = false;
    const bf16 *GR, *GB; bf16* MIX;
    static constexpr bool LATE = true;
    __device__ __forceinline__ u32x2 gload(const bf16* G, int row, int col) const { return *(const u32x2*)(G + (size_t)row * DM + col); }
    __device__ __forceinline__ void mid(f32x4& acc, int row, int col) const { const u32x2 w = *(const u32x2*)(GR + (size_t)row * DM + col); acc = acc * (f32x4){bflo(w.x), bfhi(w.x), bflo(w.y), bfhi(w.y)}; }
    __device__ __forceinline__ float fin(const f32x4& acc, int row, int col) const { const u32x2 w = *(const u32x2*)(GB + (size_t)row * DM + col);
        const f32x4 v = acc * (f32x4){bflo(w.x), bfhi(w.x), bflo(w.y), bfhi(w.y)}; u32x2 o; o.x = cvtpk(v.x, v.y); o.y = cvtpk(v.z, v.w); *(u32x2*)(MIX + (size_t)row * DM + col) = o; return 0.f; }
};
struct MiniRes {
    static constexpr bool MIDK = false, POST = true, LATE = true;
    const float* xin_s; const bf16* xbf; const float* gsi; float* xout; const float* gate; const float* gs; bf16* XS; float* SS;
    __device__ __forceinline__ void mid(f32x4&, int, int) const {}
    __device__ __forceinline__ u32x2 xload(int row, int col) const { return xbf ? *(const u32x2*)(xbf + (size_t)row * DM + col) : (u32x2){0u, 0u}; }
    __device__ __forceinline__ float fin(const f32x4& acc, int row, int col) const { return fin_x(acc, xload(row, col), row, col); }
    __device__ __forceinline__ float fin_x(const f32x4& acc, const u32x2 w, int row, int col) const {
        const int bidx = NBATCH + ((row - MP) >> 4);
        const f32x4 g = *(const f32x4*)(gate + (size_t)bidx * 6144 + col);
        f32x4 x;
        if (xbf) { x = (f32x4){bflo(w.x), bfhi(w.x), bflo(w.y), bfhi(w.y)} * *(const f32x4*)(gsi + (size_t)bidx * DM + col); }
        else x = *(const f32x4*)(xin_s + (size_t)(row - MP) * DM + col);
        const f32x4 xn = x + g * acc;
        if (xout) *(f32x4*)(xout + (size_t)row * DM + col) = xn;
        if (gs) { const f32x4 y = xn * *(const f32x4*)(gs + (size_t)bidx * DM + col); u32x2 o; o.x = cvtpk(y.x, y.y); o.y = cvtpk(y.z, y.w); *(u32x2*)(XS + (size_t)row * DM + col) = o; }
        return (xn.x * xn.x + xn.y * xn.y) + (xn.z * xn.z + xn.w * xn.w); }
};
template <class Em> struct StripT {
    static constexpr bool ON = true, LATE = Em::LATE;
    const bf16* zA; Em em;
    __device__ __forceinline__ void mid(f32x4& accx, const pg8::Unit& u, int wr, int wc, int fr, int fq) const { asm volatile("" : "+v"(fr), "+v"(fq));
        em.mid(accx, MP + (u.pm >> 1) * 16 + fr, u.pn * 256 + (u.pm & 1) * 128 + wc * 32 + 8 * fq + 4 * wr); }
    __device__ __forceinline__ void fin(const f32x4& accx, const pg8::Unit& u, int wr, int wc, int fr, int fq, LAS unsigned char* red_, int wid) const {
        asm volatile("" : "+v"(fr), "+v"(fq));
        const int row0 = MP + (u.pm >> 1) * 16;
        float ss = em.fin(accx, row0 + fr, u.pn * 256 + (u.pm & 1) * 128 + wc * 32 + 8 * fq + 4 * wr);
        if constexpr (Em::POST) {
            ss += __builtin_bit_cast(float, __builtin_amdgcn_ds_swizzle(__builtin_bit_cast(int, ss), 0x401F)); ss = swapsum(ss);
            LAS float* red = (LAS float*)red_;
            if (fq == 0) red[fr * 8 + wid] = ss;
        } else { (void)ss; (void)red_; (void)wid; }
    }
    __device__ __forceinline__ u32x2 mid_load(const pg8::Unit& u, int wr, int wc, int fr, int fq) const { asm volatile("" : "+v"(fr), "+v"(fq));
        if constexpr (Em::MIDK) return em.gload(em.GR, MP + (u.pm >> 1) * 16 + fr, u.pn * 256 + (u.pm & 1) * 128 + wc * 32 + 8 * fq + 4 * wr); else return (u32x2){0u, 0u}; }
    __device__ __forceinline__ void mid_apply(f32x4& accx, const u32x2 w) const { accx = accx * (f32x4){bflo(w.x), bfhi(w.x), bflo(w.y), bfhi(w.y)}; }
    __device__ __forceinline__ u32x2 fin_load(const pg8::Unit& u, int wr, int wc, int fr, int fq) const { asm volatile("" : "+v"(fr), "+v"(fq));
        const int row = MP + (u.pm >> 1) * 16 + fr, col = u.pn * 256 + (u.pm & 1) * 128 + wc * 32 + 8 * fq + 4 * wr;
        if constexpr (Em::MIDK) return em.gload(em.GB, row, col); else return em.xload(row, col); }
    __device__ __forceinline__ void fin_apply(const f32x4& accx, const u32x2 w, const pg8::Unit& u, int wr, int wc, int fr, int fq, LAS unsigned char* red_, int wid) const { asm volatile("" : "+v"(fr), "+v"(fq));
        const int row = MP + (u.pm >> 1) * 16 + fr, col = u.pn * 256 + (u.pm & 1) * 128 + wc * 32 + 8 * fq + 4 * wr;
        if constexpr (Em::MIDK) { const f32x4 v = accx * (f32x4){bflo(w.x), bfhi(w.x), bflo(w.y), bfhi(w.y)}; u32x2 o; o.x = cvtpk(v.x, v.y); o.y = cvtpk(v.z, v.w); *(u32x2*)(em.MIX + (size_t)row * DM + col) = o; (void)red_; (void)wid; }
        else { float ss = em.fin_x(accx, w, row, col);
            ss += __builtin_bit_cast(float, __builtin_amdgcn_ds_swizzle(__builtin_bit_cast(int, ss), 0x401F)); ss = swapsum(ss);
            LAS float* red = (LAS float*)red_; if (fq == 0) red[fr * 8 + wid] = ss; } }
    __device__ __forceinline__ void post(const pg8::Unit& u, int fr, int fq, LAS unsigned char* red_, int wid) const {
        if constexpr (Em::POST) {
            asm volatile("" : "+v"(fr), "+v"(fq));
            const int row0 = MP + (u.pm >> 1) * 16;
            LAS float* red = (LAS float*)red_;
            LDS_WAIT(); __builtin_amdgcn_s_barrier(); asm volatile("" ::: "memory");
            const int l_ = fr;
            if (wid == 0 && fq == 0 && em.SS) { const LAS f32x4* r = (const LAS f32x4*)(red + l_ * 8); const f32x4 a = r[0], b = r[1]; const int slot = u.pn * 2 + (u.pm & 1);
                em.SS[(size_t)(row0 + l_) * 16 + slot] = ((a.x + a.y) + (a.z + a.w)) + ((b.x + b.y) + (b.z + b.w)); em.SS[(size_t)(row0 + l_) * 16 + slot + 8] = 0.f; }
        }
    }
};
constexpr int MG_BUF = 49152;
template <class Epi> __device__ __forceinline__ void mini_gemm(Frame& F, const bf16* Ab  , const bf16* Bt  , int K, const Epi& E) {
    int tid_ = F.tid; asm volatile("" : "+v"(tid_));
    const int lane_ = tid_ & 63, fr = lane_ & 15, fq = lane_ >> 4;
    const int rg = F.wave >> 2, cg = F.wave & 3, nb = K >> 8;
    for (int tile = F.vcu; tile < 256; tile += F.G) {
        const int rowb = MP + (tile >> 4) * 32, cb = tile & 15;
        const bf16* src[6];
#pragma unroll
        for (int j = 0; j < 6; ++j) { const int p = j * 512 + tid_, hr = p >> 4, c = p & 15, row = hr >> 1, h = hr & 1;
            const bf16* rp = row < 32 ? Ab + (size_t)(rowb + row) * K : Bt + (size_t)(cb * 64 + row - 32) * K;
            src[j] = rp + h * 128 + ((c ^ (row & 15)) * 8); }
#define MG_ISSUE(b_) do { _Pragma("unroll") for (int j = 0; j < 6; ++j) \
        __builtin_amdgcn_global_load_lds((const unsigned*)(src[j] + (size_t)(b_) * 256), (LAS unsigned*)(F.lds + ((b_) & 1) * MG_BUF + j * 8192 + F.wave * 1024), 16, 0, 0); } while (0)
        const int aoff = (rg * 16 + fr) * 512, boff = (32 + cg * 16 + fr) * 512;
        f32x4 acc = {0.f, 0.f, 0.f, 0.f};
        MG_ISSUE(0);
        for (int b = 0; b < nb; ++b) {
            if (b + 1 < nb) { MG_ISSUE(b + 1); asm volatile("s_waitcnt vmcnt(6)" ::: "memory"); } else asm volatile("s_waitcnt vmcnt(0)" ::: "memory");
            __builtin_amdgcn_s_barrier(); asm volatile("" ::: "memory");
            const LAS unsigned char* bufp = F.lds + (b & 1) * MG_BUF;
#pragma unroll
            for (int s = 0; s < 8; ++s) { const int so = (s >> 2) * 256 + ((((s & 3) * 4 + fq) ^ fr) * 16);
                const bf16x8 a = *(const LAS bf16x8*)(bufp + aoff + so), bw = *(const LAS bf16x8*)(bufp + boff + so);
                acc = __builtin_amdgcn_mfma_f32_16x16x32_bf16(bw, a, acc, 0, 0, 0); }
            if (Epi::MIDK) { if (b * 2 + 2 == nb) E.mid(acc, rowb + rg * 16 + fr, cb * 64 + cg * 16 + 4 * fq); }
            asm volatile("s_waitcnt lgkmcnt(0)" ::: "memory"); __builtin_amdgcn_s_barrier(); asm volatile("" ::: "memory");
        }
#undef MG_ISSUE
        float ss = E.fin(acc, rowb + rg * 16 + fr, cb * 64 + cg * 16 + 4 * fq);
        if constexpr (Epi::POST) {
            ss += __shfl_xor(ss, 16); ss += __shfl_xor(ss, 32);
            LAS float* red = (LAS float*)F.lds;
            __syncthreads();
            if (fq == 0) red[(rg * 16 + fr) * 4 + cg] = ss;
            __syncthreads();
            if (tid_ < 32 && E.SS) { const LAS float* r = red + tid_ * 4; E.SS[(size_t)(rowb + tid_) * 16 + cb] = (r[0] + r[1]) + (r[2] + r[3]); }
            LDS_WAIT(); __syncthreads();
        }
    }
}

#ifndef MK_PER_PHASE
#define MK_PER_PHASE 0
#endif
#ifndef STRIP_C
#define STRIP_C 1
#endif
#ifndef STRIP_D
#define STRIP_D 1
#endif
#ifndef STRIP_F
#define STRIP_F 1
#endif
#ifndef DMAF_A
#define DMAF_A false
#endif
#ifndef DMAF_E
#define DMAF_E false
#endif
#ifndef ASMDMA_A
#define ASMDMA_A false
#endif
#ifndef ASMDMA_E
#define ASMDMA_E true
#endif
#ifndef ASMDMA_C
#define ASMDMA_C false
#endif
#ifndef ASMDMA_D
#define ASMDMA_D true
#endif
#ifndef ASMDMA_F
#define ASMDMA_F true
#endif
constexpr int CV_TAIL_E = CV_I_IN + 2 * CV_I_OA + CV_I_O + CV_I_F1;
constexpr int N_PHASES = 2 + 6 * DEPTH;

__global__ void __launch_bounds__(NWAVES * 64, 2) fwd_kernel(Args args) {
    extern __shared__ __attribute__((aligned(16))) unsigned char lds[];
    Frame F;
    F.lds = (LAS unsigned char*)lds;
    F.MISC = (volatile LAS unsigned*)(F.lds + MISC_OFF);
    F.tid = threadIdx.x; F.lane = F.tid & 63; F.wave = __builtin_amdgcn_readfirstlane(F.tid >> 6);
    F.G = gridDim.x; { const int bx = blockIdx.x; F.vcu = (F.G % 8 == 0) ? (bx % 8) * (F.G / 8) + bx / 8 : bx; }
    F.ws = args.ws; F.out = args.out; F.ctl = (gu32*)(args.ws + WS_CTL);
    for (int u = F.tid; u < (LDS_BYTES - LDSCTL_OFF) / 4; u += NWAVES * 64) ((LAS unsigned*)(F.lds + LDSCTL_OFF))[u] = 0u;
    __syncthreads();
    XcdBarrier bar; bar.bar = (unsigned*)(F.ctl + CW_BAR); bar.x = 0; bar.st = nullptr;
    if (!MK_PER_PHASE) bar = xcd_barrier_post((unsigned*)(F.ctl + CW_BAR), F.MISC + 8);
    const int lo = args.ph_lo, hi = args.ph_hi;
#ifndef ONLY
#define ONLY -1
#endif
#define EN(t) (ONLY < 0 || ONLY == (t))
#ifndef REP_PH
#define REP_PH -1
#endif
#ifndef REP_N
#define REP_N 2
#endif
#define REPL(k) for (int reps_ = [] { int r = (REP_PH == (k)) ? REP_N : 1; asm volatile("" : "+s"(r)); return r; }(), r_ = 0; r_ < reps_; ++r_)
#define IN(k) (lo <= (k) && (k) < hi)
#define SEAM(k) do { if (IN(k) && IN((k) + 1)) xcd_barrier(bar); } while (0)

    if (EN(0) && IN(0)) REPL(0) { convert_items(F, args, 0, F.G == 256 ? CV_I_IN : DEPTH * CV_PER_L, F.vcu, F.G); p0_mod(F, args); } SEAM(0);
    if (EN(1) && IN(1)) REPL(1) { p1_pass(F, args); } SEAM(1);
    for (int l = 0; l < DEPTH; ++l) {
        const int pb = 2 + 6 * l;
        const float* GS = (const float*)(F.ws + WS_GS) + (size_t)l * 2 * NMODB * DM;
        unsigned char* wl = F.ws + WS_W + (size_t)l * W_LAYER;
        unsigned char* act = F.ws + WS_ACT;
        const float* MOD = (const float*)(F.ws + WS_MOD) + (size_t)l * NMODB * 6144;
        if (EN(2) && IN(pb + 0)) REPL(2) {
            pg8::Gemm g{(const bf16*)(F.ws + WS_H), (const bf16*)(wl + W_IN), MT, DIN, DM}; typedef pg8::SmpSwapOrderT<MT / 256, DIN / 256, MP / 256, 2> SO; SO S; { int bid_ = (int)blockIdx.x; asm volatile("" : "+s"(bid_)); S.init(F.G, bid_); }
            pg8::EpiIn E{act, (float*)(F.ws + WS_VSS), F.out, args.in[F_IN_QG] + l * HD, args.in[F_IN_KG] + l * HD, (const LAS float*)(F.lds + RTAB_OFF), (const LAS float*)(F.lds + EPIV_OFF), (const float*)(F.ws + WS_CV1) + (size_t)l * NMODB * DIN, l};
            auto pre = [&] { phase_prepass<false>(F, S, E.cv, DIN, nullptr, nullptr); };
            pg8::gemm_phase<pg8::EpiIn, SO, true, true, pg8::NoStrip, decltype(pre), ASMDMA_A, DMAF_A>(F.lds, g, S, E, pg8::NoStrip(), pre);
            { pg8::Unit tu; constexpr int nfull = SO::nwg / 256, rem = SO::nwg - nfull * 256;
                if (F.G == 256 && !S.next(nfull, tu)) convert_items(F, args, l * CV_PER_L + CV_I_IN, l * CV_PER_L + CV_TAIL_E, (int)blockIdx.x - rem, 256 - rem); }
#if REP_PH >= 0
            __syncthreads();
#endif
        }
        SEAM(pb + 0);
        if (EN(3) && IN(pb + 1)) REPL(3) { mixer_phase(F, args, l); }
        SEAM(pb + 1);
        if (EN(4) && IN(pb + 2)) REPL(4) {
            pg8::Gemm g{(const bf16*)(act + A_OAB), (const bf16*)(wl + W_AB), MP, DM, DM}; typedef pg8::StaticOrderT<MP / 256, DM / 256> SO; SO S; { int bid_ = (int)blockIdx.x; asm volatile("" : "+s"(bid_)); S.init(F.G, bid_); }
            pg8::EpiOutAB E{(const bf16*)(act + A_GR), (const bf16*)(act + A_GB), (bf16*)(act + A_MIX)};
            MiniOutAB Em{(const bf16*)(act + A_GR), (const bf16*)(act + A_GB), (bf16*)(act + A_MIX)};
            #if STRIP_C
            { const StripT<MiniOutAB> Z{(const bf16*)(act + A_OAB) + (size_t)MP * DM, Em}; pg8::gemm_phase<pg8::EpiOutAB, SO, true, true, StripT<MiniOutAB>, pg8::NoPre, ASMDMA_C>(F.lds, g, S, E, Z); }
#else
            { pg8::gemm_phase<pg8::EpiOutAB, SO, true, true>(F.lds, g, S, E); mini_gemm<MiniOutAB>(F, (const bf16*)(act + A_OAB), (const bf16*)(wl + W_AB), DM, Em); }
#endif
            ;
        }
        SEAM(pb + 2);
        if (EN(5) && IN(pb + 3)) for (int reps_ = [&] { int r = (REP_PH == 5 && l == 0) ? 2 : 1; asm volatile("" : "+s"(r)); return r; }(), r_ = 0; r_ < reps_; ++r_) {
            pg8::Gemm g{(const bf16*)(act + A_MIX), (const bf16*)(wl + W_O), MP, DM, DM}; typedef pg8::StaticOrderT<MP / 256, DM / 256> SO; SO S; { int bid_ = (int)blockIdx.x; asm volatile("" : "+s"(bid_)); S.init(F.G, bid_); }
            const float* GSI = (const float*)(F.ws + WS_GSI) + (size_t)l * 2 * NMODB * DM;

            MiniRes Em{nullptr, (const bf16*)(F.ws + WS_H), GSI, nullptr, MOD + 2 * DM, GS + NMODB * DM, (bf16*)(F.ws + WS_H), (float*)(F.ws + WS_SS)};
            { pg8::EpiRes<true> E{nullptr, (const bf16*)(F.ws + WS_H), GSI, nullptr, MOD + 2 * DM, GS + NMODB * DM, (bf16*)(F.ws + WS_H), (float*)(F.ws + WS_SS)};
              #if STRIP_D
            { const StripT<MiniRes> Z{(const bf16*)(act + A_MIX) + (size_t)MP * DM, Em}; pg8::gemm_phase<pg8::EpiRes<true>, SO, true, true, StripT<MiniRes>, pg8::NoPre, ASMDMA_D>(F.lds, g, S, E, Z); }
#else
            { pg8::gemm_phase<pg8::EpiRes<true>, SO, true, true>(F.lds, g, S, E); mini_gemm<MiniRes>(F, (const bf16*)(act + A_MIX), (const bf16*)(wl + W_O), DM, Em); }
#endif
            }
        }
        SEAM(pb + 3);
        if (EN(7) && IN(pb + 4)) REPL(7) {
            pg8::Gemm g{(const bf16*)(F.ws + WS_H), (const bf16*)(wl + W_F1), MT, 2 * DFF, DM}; typedef pg8::SmpSwapOrderT<MT / 256, 2 * DFF / 256, MP / 256, 2> SO; SO S; { int bid_ = (int)blockIdx.x; asm volatile("" : "+s"(bid_)); S.init(F.G, bid_); }
            pg8::EpiFfnIn E{(bf16*)(act + A_ACT), (float*)(act + A_SIDE), F.out, args.in[F_IN_CW] + (size_t)l * 3 * DFF, args.in[F_IN_CB] + (size_t)l * DFF, args.in[F_IN_CC] + (size_t)l * DECB * 2 * DFF,
                            (LAS float*)(F.lds + RING_BYTES), (const LAS float*)(F.lds + RTAB_OFF), (const LAS float*)(F.lds + EPIV_OFF), (const float*)(F.ws + WS_CV2) + (size_t)l * NMODB * 2 * DFF, l};
            auto pre = [&] { phase_prepass<true>(F, S, E.cv, 2 * DFF, E.cw, E.cb); };
            pg8::gemm_phase<pg8::EpiFfnIn, SO, true, true, pg8::NoStrip, decltype(pre), ASMDMA_E, DMAF_E>(F.lds, g, S, E, pg8::NoStrip(), pre);
            { pg8::Unit tu; constexpr int nfull = SO::nwg / 256, rem = SO::nwg - nfull * 256;
                if (F.G == 256 && !S.next(nfull, tu)) convert_items(F, args, l * CV_PER_L + CV_TAIL_E, l + 1 < DEPTH ? (l + 1) * CV_PER_L + CV_I_IN : DEPTH * CV_PER_L, (int)blockIdx.x - rem, 256 - rem); }
#if REP_PH >= 0
            __syncthreads();
#endif
        }
        SEAM(pb + 4);
        if (EN(9) && IN(pb + 5)) {
            pg8::Gemm g{(const bf16*)(act + A_ACT), (const bf16*)(wl + W_F2), MP, DM, DFF}; typedef pg8::StaticOrderT<MP / 256, DM / 256> SO; SO S; { int bid_ = (int)blockIdx.x; asm volatile("" : "+s"(bid_)); S.init(F.G, bid_); }
            { pg8::Unit fu; for (int i = 0; S.next(i, fu); ++i) ffn_fixup(F, args, l, fu.pm); VM_WAIT(); __syncthreads(); }
            const float* gsn = l + 1 < DEPTH ? GS + 2 * NMODB * DM : nullptr;
            const float* GSI2 = (const float*)(F.ws + WS_GSI) + (size_t)l * 2 * NMODB * DM + NMODB * DM;
            pg8::EpiRes<true> E{nullptr, (const bf16*)(F.ws + WS_H), GSI2, gsn ? nullptr : F.out, MOD + 5 * DM, gsn, (bf16*)(F.ws + WS_H), (float*)(F.ws + WS_SS)};
            MiniRes Em{nullptr, (const bf16*)(F.ws + WS_H), GSI2, gsn ? nullptr : F.out, MOD + 5 * DM, gsn, (bf16*)(F.ws + WS_H), gsn ? (float*)(F.ws + WS_SS) : nullptr};
            #if STRIP_F
            { const StripT<MiniRes> Z{(const bf16*)(act + A_ACT) + (size_t)MP * DFF, Em}; pg8::gemm_phase<pg8::EpiRes<true>, SO, true, true, StripT<MiniRes>, pg8::NoPre, ASMDMA_F>(F.lds, g, S, E, Z); }
#else
            { pg8::gemm_phase<pg8::EpiRes<true>, SO, true, true>(F.lds, g, S, E); mini_gemm<MiniRes>(F, (const bf16*)(act + A_ACT), (const bf16*)(wl + W_F2), DFF, Em); }
#endif
            ;
        }
        SEAM(pb + 5);
    }
#undef IN
#undef SEAM
}

extern "C" void kernel_launch(void* const* d_in, const int* in_sizes, int n_in, void* d_out, int out_size, void* d_ws, size_t ws_size, hipStream_t stream) {
    static int grid = 0;
    if (grid == 0) {
        if (n_in != 25 || in_sizes[0] != MP * DM || out_size != (int)O_END || ws_size < WS_END) {
            fprintf(stderr, "kernel_launch: unexpected problem: n_in %d in0 %d out %d ws %zu (need %zu); nothing launched\n", n_in, n_in > 0 ? in_sizes[0] : -1, out_size, ws_size, (size_t)WS_END); grid = -1; return; }
        int dev = 0, cus = 0, per_cu = 0;
        if (hipGetDevice(&dev) != hipSuccess || hipDeviceGetAttribute(&cus, hipDeviceAttributeMultiprocessorCount, dev) != hipSuccess) { fprintf(stderr, "kernel_launch: device query failed\n"); grid = -1; return; }
        if (hipFuncSetAttribute((const void*)fwd_kernel, hipFuncAttributeMaxDynamicSharedMemorySize, LDS_BYTES) != hipSuccess) { fprintf(stderr, "kernel_launch: hipFuncSetAttribute failed\n"); grid = -1; return; }
        if (hipOccupancyMaxActiveBlocksPerMultiprocessor(&per_cu, (const void*)fwd_kernel, NWAVES * 64, LDS_BYTES) != hipSuccess || per_cu < 1) {
            fprintf(stderr, "kernel_launch: occupancy query reports %d workgroups per CU\n", per_cu); per_cu = 1; }
        (void)hipGetLastError();
        grid = cus;
    }
    if (grid < 0) return;
    if (hipMemsetAsync((char*)d_ws + WS_CTL, 0, CTL_ZERO_BYTES, stream) != hipSuccess) { fprintf(stderr, "kernel_launch: memset failed\n"); return; }
    Args a{};
    for (int i = 0; i < 25; ++i) a.in[i] = (const float*)d_in[i];
    a.out = (float*)d_out; a.ws = (unsigned char*)d_ws;
#if MK_PER_PHASE
    for (int ph = 0; ph < N_PHASES; ++ph) { a.ph_lo = ph; a.ph_hi = ph + 1; hipLaunchKernelGGL(fwd_kernel, dim3(grid), dim3(NWAVES * 64), LDS_BYTES, stream, a); }
#else
    a.ph_lo = 0; a.ph_hi = N_PHASES;
    hipLaunchKernelGGL(fwd_kernel, dim3(grid), dim3(NWAVES * 64), LDS_BYTES, stream, a);
#endif
    const hipError_t le = hipPeekAtLastError();
    if (le != hipSuccess) fprintf(stderr, "kernel_launch: launch failed: %s\n", hipGetErrorName(le));
}
```

```cpp
#include <hip/hip_runtime.h>
#include <cstdio>
#include <cstdint>

constexpr int DM = 1024, NBATCH = 2, SEQ = 8192, DEPTH = 2, DECB = 32, DECT = 16;
constexpr int MP = NBATCH * SEQ, MS = DECB * DECT, MT = MP + MS;
constexpr int NH = 8, HD = 64, DA = 512, DB = 512, NG = 4, GD = 128, DFF = 2816, DIN = 4608, NREL = 257;
constexpr int NMODB = NBATCH + DECB;
constexpr float EPS = 1e-6f;
constexpr float LOG2E = 1.4426950408889634f;
constexpr float QSCALE = 0.125f * LOG2E;
constexpr size_t O_Y = 0, O_KP = (size_t)MT * DM, O_VP = O_KP + (size_t)DEPTH * NBATCH * 512 * 512, O_CP = O_VP + (size_t)DEPTH * NBATCH * 512 * 512,
                 O_KS = O_CP + (size_t)DEPTH * NBATCH * 2 * DFF, O_VS = O_KS + (size_t)DEPTH * DECB * DECT * 512, O_BS = O_VS + (size_t)DEPTH * DECB * DECT * 512,
                 O_CS = O_BS + (size_t)DEPTH * DECB * DECT * 512, O_END = O_CS + (size_t)DEPTH * DECB * 2 * DFF;
static_assert(O_END == 21354496, "output size");

constexpr size_t MiB = 1u << 20;
constexpr size_t WS_CTL = 0, CTL_ZERO_BYTES = 64 * 1024;
constexpr size_t WS_MOD = 1 * MiB;
constexpr size_t WS_VSS = 3 * MiB;
constexpr size_t WS_GS = 4 * MiB;
constexpr size_t WS_CV1 = 5 * MiB;
constexpr size_t WS_CV2 = 7 * MiB;
constexpr size_t WS_SS = 9 * MiB;
constexpr size_t WS_GSI = 10 * MiB + 512 * 1024;
constexpr size_t WS_W = 12 * MiB;
constexpr size_t W_IN = 0, W_AB = (size_t)DIN * DM * 2, W_O = W_AB + (size_t)DM * DM * 2, W_F1 = W_O + (size_t)DM * DM * 2, W_F2 = W_F1 + (size_t)2 * DFF * DM * 2,
                 W_LAYER = W_F2 + (size_t)DM * DFF * 2;
constexpr size_t WS_H = 76 * MiB;
constexpr size_t WS_ACT = 110 * MiB;
constexpr size_t A_Q = 0, A_K = A_Q + (size_t)MT * 512 * 2, A_V = A_K + (size_t)MT * 512 * 2, A_UB = A_V + (size_t)MT * 512 * 2, A_VB = A_UB + (size_t)MT * 512 * 2,
                 A_GR = A_VB + (size_t)MT * 512 * 2, A_GB = A_GR + (size_t)MT * DM * 2, A_OAB = A_GB + (size_t)MT * DM * 2, A_MIX = A_OAB + (size_t)MT * DM * 2,
                 A_END = A_MIX + (size_t)MT * DM * 2;
constexpr size_t A_ACT = 0;
constexpr size_t SIDE_N = (size_t)66 * 2 * DFF;
constexpr size_t A_SIDE = 216 * MiB;
constexpr size_t WS_END = WS_ACT + 240 * MiB;
static_assert(WS_GS + (size_t)DEPTH * 2 * NMODB * DM * 4 <= WS_CV1 && WS_CV1 + (size_t)DEPTH * NMODB * DIN * 4 <= WS_CV2 && WS_CV2 + (size_t)DEPTH * NMODB * 2 * DFF * 4 <= WS_SS && WS_SS + (size_t)MT * 16 * 4 <= WS_GSI && WS_GSI + (size_t)DEPTH * 2 * NMODB * DM * 4 <= WS_W, "small buffers");
static_assert(WS_W + 2 * W_LAYER <= WS_H && WS_H + (size_t)MT * DM * 2 <= WS_ACT && A_END <= A_SIDE && A_ACT + (size_t)MT * DFF * 2 <= A_SIDE && A_SIDE + 3 * 66 * 2 * (size_t)DFF * 4 <= 240 * MiB, "d_ws map");
constexpr int CW_BAR = 1024;

namespace pg8 {
#define PG8_LAS __attribute__((address_space(3)))
typedef unsigned short bf16_t;
typedef short bf16x8 __attribute__((ext_vector_type(8)));
typedef float f32x4 __attribute__((ext_vector_type(4)));
typedef unsigned u32x4 __attribute__((ext_vector_type(4)));
constexpr int BM = 256, BK = 64, HALF = 128, HTB = HALF * BK * 2  , STAGE_BYTES = 8 * HTB, NXCD = 8, WGM = 8;

__host__ __device__ __forceinline__ int lds_byte(int r, int c) { const int st = (r >> 4) * 2 + (c >> 5), rr = r & 15, cc = c & 31, ob = rr * 64 + cc * 2; return st * 1024 + (ob ^ (((ob >> 9) & 1) << 5)); }
__host__ __device__ __forceinline__ void stage_rc(int b, int& R, int& C) { const int st = b / 1024, sb = b % 1024, swz = sb ^ (((sb >> 9) & 1) << 5); R = (st >> 1) * 16 + swz / 64; C = (st & 1) * 32 + (swz % 64) / 2; }
__host__ __device__ __forceinline__ int perm32(int rho) { const int n = rho >> 4, i = rho & 15; return 8 * (i >> 2) + 4 * n + (i & 3); }

struct NoStrip { static constexpr bool ON = false, LATE = false; };
struct NoPre { __device__ __forceinline__ void operator()() const {} };
struct Unit { int pm, pn, ui; };
struct Gemm { const bf16_t* A; const bf16_t* Bt; int M, N, K; };

template <int NM_, int NN_> struct StaticOrderT {
    static constexpr int nM = NM_, nN = NN_, nwg = NM_ * NN_;
    int G, c;
    __host__ __device__ void init(int G_, int c_) { G = G_; c = c_; }
    __host__ __device__ __forceinline__ bool next(int i, Unit& u) const {
        const int L = i * G + c; if (L >= nwg) return false;
        int wgid = L; { constexpr int q = nwg / NXCD, r = nwg % NXCD; const int xcd = wgid % NXCD, off = wgid / NXCD; wgid = (xcd < r ? xcd * (q + 1) : r * (q + 1) + (xcd - r) * q) + off; }
        constexpr int nig = WGM * nN; const int gid = wgid / nig, fm = gid * WGM, gsz = (nM - fm) < WGM ? (nM - fm) : WGM, rem = wgid % nig;
        if (gsz == WGM) { u.pm = fm + (rem % WGM); u.pn = rem / WGM; } else { u.pm = fm + (rem % gsz); u.pn = rem / gsz; }
        u.ui = i; return true;
    }
    __device__ __forceinline__ void a_ready(const Unit&) const {}
    __device__ __forceinline__ void done(const Unit&) const {}
};
template <int NM_, int NN_, int NMP_, int RND_> struct SmpSwapOrderT {
    typedef StaticOrderT<NM_, NN_> Base;
    static constexpr int nM = NM_, nN = NN_, nwg = NM_ * NN_, NSMP = (NM_ - NMP_) * NN_;
    Base b;
    __host__ __device__ void init(int G_, int c_) { b.init(G_, c_); }
    __host__ __device__ __forceinline__ bool next(int i, Unit& u) const {
        if (!b.next(i, u)) return false;
        if (b.G == 256) {
            if (u.pm >= NMP_) { const int s = (u.pm - NMP_) * NN_ + u.pn; Base t; t.init(256, 255 - s); Unit v; v.pm = 0; v.pn = 0; v.ui = 0; t.next(RND_, v); u.pm = v.pm; u.pn = v.pn; }
            else if (i == RND_ && b.c >= 256 - NSMP) { const int s = 255 - b.c; u.pm = NMP_ + s / NN_; u.pn = s % NN_; }
        }
        return true;
    }
    __device__ __forceinline__ void a_ready(const Unit&) const {}
    __device__ __forceinline__ void done(const Unit&) const {}
};


__device__ __forceinline__ unsigned cvt_pk_bf16(float lo, float hi) { unsigned r; asm volatile("v_cvt_pk_bf16_f32 %0, %1, %2" : "=v"(r) : "v"(lo), "v"(hi)); return r; }
__device__ __forceinline__ float bf_lo(unsigned w) { return __uint_as_float(w << 16); }
__device__ __forceinline__ float bf_hi(unsigned w) { return __uint_as_float(w & 0xffff0000u); }
__device__ __forceinline__ float gelu_tanh(float x) {
    const float t = x * (-2.0f * LOG2E * 0.7978845608028654f + (-2.0f * LOG2E * 0.035677408136300125f) * (x * x));
    return x * __builtin_amdgcn_rcpf(1.0f + __builtin_amdgcn_exp2f(t));
}
__device__ __forceinline__ u32x4 pack8(const f32x4 a, const f32x4 b) { u32x4 w; w.x = cvt_pk_bf16(a[0], a[1]); w.y = cvt_pk_bf16(a[2], a[3]); w.z = cvt_pk_bf16(b[0], b[1]); w.w = cvt_pk_bf16(b[2], b[3]); return w; }


__device__ __forceinline__ int row_bidx(int row) { return row < MP ? (row >> 13) : NBATCH + ((row - MP) >> 4); }

__device__ __forceinline__ float rowsum4(float v, int fr, int fq) {
    const int l4 = ((fq << 4) | fr) << 2;
    v += __builtin_bit_cast(float, __builtin_amdgcn_ds_bpermute(l4 ^ (16 << 2), __builtin_bit_cast(int, v)));
    v += __builtin_bit_cast(float, __builtin_amdgcn_ds_bpermute(l4 ^ (32 << 2), __builtin_bit_cast(int, v)));
    return v;
}
struct EpiIn {
    static constexpr bool PERM = true, AFTER_DRAIN = false, MIDK = false;
    unsigned char* act; float* VSS; float* out; const float* qg; const float* kg; const PG8_LAS float* rtab; const PG8_LAS float* ev; const float* cv; int layer;
    __device__ __forceinline__ void operator()(const f32x4 (&acc)[2][2][4][2], const Unit& u, int wr, int wc, int fr, int fq) const {
        const int pn = u.pn, rowt = u.pm * BM + wr * 64 + fr;
        const bool smp = u.pm >= 64;
        const int ca0 = pn * 256 + 32 * wc + 8 * fq, cast = HALF;
        f32x4 cvv[2][2];
        if (!smp) {
#pragma unroll
            for (int bj = 0; bj < 2; ++bj)
#pragma unroll
                for (int n = 0; n < 2; ++n) cvv[bj][n] = *(const PG8_LAS f32x4*)(ev + u.ui * 768 + 32 * wc + 8 * fq + bj * cast + 4 * n);
        }
        const float zsc = pn >= 10 ? -LOG2E : 1.0f;
        if (!smp && pn >= 10) {
#pragma unroll
            for (int bj = 0; bj < 2; ++bj)
#pragma unroll
                for (int n = 0; n < 2; ++n) cvv[bj][n] = cvv[bj][n] * -LOG2E; }
        if (smp) { const float* cp = cv + (size_t)(NBATCH + ((rowt - MP) >> 4)) * DIN + ca0;
#pragma unroll
            for (int bj = 0; bj < 2; ++bj)
#pragma unroll
                for (int n = 0; n < 2; ++n) cvv[bj][n] = *(const f32x4*)(cp + bj * cast + 4 * n); }
        const int which = pn >> 1, half = pn & 1;
        f32x4 gv[2][2];
        if (pn < 4) {
#pragma unroll
            for (int bj = 0; bj < 2; ++bj)
#pragma unroll
                for (int n = 0; n < 2; ++n) gv[bj][n] = *(const f32x4*)((which == 0 ? qg : kg) + 32 * bj + 8 * fq + 4 * n);
        }
        float* fo = nullptr;
        if (pn >= 2 && pn < 6) {
            const int colb = half * 256 + 64 * wc + 8 * fq;
            if (!smp) { if ((u.pm & 31) >= 30) fo = out + O_KP + (size_t)(which - 1) * (O_VP - O_KP) + ((size_t)(layer * NBATCH + (u.pm >> 5)) * 512 + ((u.pm & 31) - 30) * 256 + wr * 64 + fr) * 512 + colb; }
            else fo = out + O_KS + (size_t)(which - 1) * (O_VS - O_KS) + (size_t)layer * (DECB * DECT * 512) + (size_t)((u.pm - 64) * 256 + wr * 64 + fr) * 512 + colb;
        }
#pragma unroll
        for (int ai = 0; ai < 2; ++ai)
#pragma unroll
            for (int m = 0; m < 4; ++m) {
                const size_t roff = (size_t)(ai * HALF + m * 16);
                const size_t row = (size_t)rowt + roff;
                const float rstd = rtab[u.ui * 256 + (int)roff + wr * 64 + fr] * zsc;
                f32x4 v[2][2];
                if (!smp) {
#pragma unroll
                    for (int bj = 0; bj < 2; ++bj)
#pragma unroll
                        for (int n = 0; n < 2; ++n) v[bj][n] = acc[ai][bj][m][n] * rstd + cvv[bj][n];
                } else {
#pragma unroll
                    for (int bj = 0; bj < 2; ++bj)
#pragma unroll
                        for (int n = 0; n < 2; ++n) v[bj][n] = acc[ai][bj][m][n] * rstd + cvv[bj][n] * zsc;
                }
                if (smp && ai * 4 + m + 1 < 8) {
                    const int gn = ai * 4 + m + 1; const float* cp = cv + (size_t)(NBATCH + ((rowt + (gn >> 2) * HALF + (gn & 3) * 16 - MP) >> 4)) * DIN + ca0;
#pragma unroll
                    for (int bj = 0; bj < 2; ++bj)
#pragma unroll
                        for (int n = 0; n < 2; ++n) cvv[bj][n] = *(const f32x4*)(cp + bj * cast + 4 * n); }
                if (pn < 6) {
                    bf16_t* dst = (bf16_t*)(act + A_Q) + (size_t)which * ((size_t)MT * 512);
                    const int colb = half * 256 + 64 * wc + 8 * fq;
                    if (which < 2) {
                        float ss = 0.f;
#pragma unroll
                        for (int bj = 0; bj < 2; ++bj)
#pragma unroll
                            for (int n = 0; n < 2; ++n) ss += (v[bj][n][0] * v[bj][n][0] + v[bj][n][1] * v[bj][n][1]) + (v[bj][n][2] * v[bj][n][2] + v[bj][n][3] * v[bj][n][3]);
                        ss = rowsum4(ss, fr, fq);
                        const float rs = __builtin_amdgcn_rsqf(ss * (1.0f / 64.0f) + EPS);
#pragma unroll
                        for (int bj = 0; bj < 2; ++bj)
#pragma unroll
                            for (int n = 0; n < 2; ++n) v[bj][n] = v[bj][n] * rs * gv[bj][n];
                    }
                    if (fo) {
#pragma unroll
                        for (int bj = 0; bj < 2; ++bj) { *(f32x4*)(fo + roff * 512 + 32 * bj) = v[bj][0]; *(f32x4*)(fo + roff * 512 + 32 * bj + 4) = v[bj][1]; }
                    }
                    const float sc = which == 0 ? QSCALE : 1.0f;
                    bf16_t* rp = dst + row * 512 + colb;
#pragma unroll
                    for (int bj = 0; bj < 2; ++bj) *(u32x4*)(rp + 32 * bj) = pack8(v[bj][0] * sc, v[bj][1] * sc);
                } else if (pn < 10) {
                    const bool isv = pn >= 8;
                    bf16_t* dst = (bf16_t*)(act + A_UB) + (isv ? (size_t)MT * 512 : 0);
                    const int colb = (pn & 1) * 256 + 64 * wc + 8 * fq;
                    float ss = 0.f;
#pragma unroll
                    for (int bj = 0; bj < 2; ++bj)
#pragma unroll
                        for (int n = 0; n < 2; ++n) {
#pragma unroll
                            for (int e = 0; e < 4; ++e) { const float g = gelu_tanh(v[bj][n][e]); v[bj][n][e] = g; ss += g * g; } }
                    if (isv) { ss = rowsum4(ss, fr, fq); if (fq == 0) VSS[row * 8 + (pn & 1) * 4 + wc] = ss; }
                    bf16_t* rp = dst + row * 512 + colb;
#pragma unroll
                    for (int bj = 0; bj < 2; ++bj) *(u32x4*)(rp + 32 * bj) = pack8(v[bj][0], v[bj][1]);
                } else {
                    const int ch = 128 * (pn - 10) + 32 * wc + 8 * fq;
                    f32x4 r[2], g[2];
#pragma unroll
                    for (int n = 0; n < 2; ++n)
#pragma unroll
                        for (int e = 0; e < 4; ++e) {
                            const float ea = __builtin_amdgcn_exp2f(fminf(fmaxf(v[0][n][e], -43.f), 43.f)), eb = __builtin_amdgcn_exp2f(fminf(fmaxf(v[1][n][e], -43.f), 43.f));
                            g[n][e] = __builtin_amdgcn_rcpf(1.0f + eb); r[n][e] = (1.0f + eb) * __builtin_amdgcn_rcpf(1.0f + ea);
                        }
                    *(u32x4*)((bf16_t*)(act + A_GR) + row * DM + ch) = pack8(r[0], r[1]);
                    *(u32x4*)((bf16_t*)(act + A_GB) + row * DM + ch) = pack8(g[0], g[1]);
                }
                asm volatile("" ::: "memory");
            }
    }
};

#ifndef OAB_AHEAD
#define OAB_AHEAD 8
#endif
struct EpiOutAB {
    static constexpr bool PERM = true, AFTER_DRAIN = false, MIDK = true;
    const bf16_t *GR, *GB; bf16_t* MIX;
    template <bool FIN> __device__ __forceinline__ void run(f32x4 (&acc)[2][2][4][2], const Unit& u, int wr, int wc, int fr_, int fq_) const {
        int fr = fr_, fq = fq_; asm volatile("" : "+v"(fr), "+v"(fq));
        const int rowt = u.pm * BM + wr * 64 + fr, colb = u.pn * BM + 32 * wc + 8 * fq;
        const bf16_t* G = FIN ? GB : GR;
        constexpr int GA = OAB_AHEAD;
        u32x4 wb[GA][2];
#define OAB_LOAD(B_, G_) do { const bf16_t* rp = G + ((size_t)rowt + ((G_) >> 2) * HALF + ((G_) & 3) * 16) * DM + colb; wb[B_][0] = *(const u32x4*)rp; wb[B_][1] = *(const u32x4*)(rp + HALF); } while (0)
#pragma unroll
        for (int g0 = 0; g0 < GA - 1; ++g0) OAB_LOAD(g0, g0);
#pragma unroll
        for (int g = 0; g < 8; ++g) {
            const int ai = g >> 2, m = g & 3;
            if (g + GA - 1 < 8) OAB_LOAD((g + GA - 1) % GA, g + GA - 1);
            __builtin_amdgcn_sched_barrier(0);
#pragma unroll
            for (int bj = 0; bj < 2; ++bj) { const u32x4 w = wb[g % GA][bj];
                const f32x4 a = acc[ai][bj][m][0] * (f32x4){bf_lo(w.x), bf_hi(w.x), bf_lo(w.y), bf_hi(w.y)};
                const f32x4 b = acc[ai][bj][m][1] * (f32x4){bf_lo(w.z), bf_hi(w.z), bf_lo(w.w), bf_hi(w.w)};
                if (FIN) *(u32x4*)(MIX + ((size_t)rowt + ai * HALF + m * 16) * DM + colb + bj * HALF) = pack8(a, b);
                else { acc[ai][bj][m][0] = a; acc[ai][bj][m][1] = b; } }
            __builtin_amdgcn_sched_barrier(0);
        }
#undef OAB_LOAD
    }
    __device__ __forceinline__ void mid(f32x4 (&acc)[2][2][4][2], const Unit& u, int wr, int wc, int fr, int fq) const { run<false>(acc, u, wr, wc, fr, fq); }
    __device__ __forceinline__ void operator()(const f32x4 (&acc)[2][2][4][2], const Unit& u, int wr, int wc, int fr, int fq) const { run<true>(const_cast<f32x4 (&)[2][2][4][2]>(acc), u, wr, wc, fr, fq); }
};

template <bool SRC_BF16> struct EpiRes {
    static constexpr bool PERM = true, AFTER_DRAIN = false, MIDK = false;
    const float* xin_p; const bf16_t* xbf; const float* gsi; float* xout; const float* gate; const float* gs; bf16_t* XS; float* SS;
    __device__ __forceinline__ void operator()(const f32x4 (&acc)[2][2][4][2], const Unit& u, int wr, int wc, int fr, int fq) const {
        const int rowt = u.pm * BM + wr * 64 + fr, colb = u.pn * BM + 32 * wc + 8 * fq, bidx = u.pm >> 5;
        const float* gp = gate + (size_t)bidx * 6144 + colb;
        f32x4 gt[2][2], gsv[2][2], giv[2][2];
#pragma unroll
        for (int bj = 0; bj < 2; ++bj)
#pragma unroll
            for (int n = 0; n < 2; ++n) { gt[bj][n] = *(const f32x4*)(gp + bj * HALF + 4 * n);
                gsv[bj][n] = gs ? *(const f32x4*)(gs + (size_t)bidx * DM + colb + bj * HALF + 4 * n) : (f32x4){0.f, 0.f, 0.f, 0.f};
                giv[bj][n] = SRC_BF16 ? *(const f32x4*)(gsi + (size_t)bidx * DM + colb + bj * HALF + 4 * n) : (f32x4){0.f, 0.f, 0.f, 0.f}; }
        u32x4 raw[2][SRC_BF16 ? 2 : 4];
#define RES_LOADX(B_, G_) do { const size_t xo = (size_t)(rowt + ((G_) >> 2) * HALF + ((G_) & 3) * 16) * DM + colb; \
        if constexpr (SRC_BF16) { raw[B_][0] = *(const u32x4*)(xbf + xo); raw[B_][1] = *(const u32x4*)(xbf + xo + HALF); } \
        else { _Pragma("unroll") for (int q_ = 0; q_ < 4; ++q_) raw[B_][q_] = *(const u32x4*)(xin_p + xo + (q_ >> 1) * HALF + 4 * (q_ & 1)); } } while (0)
        RES_LOADX(0, 0);
#pragma unroll
        for (int g = 0; g < 8; ++g) {
            const int ai = g >> 2, m = g & 3;
            if (g + 1 < 8) RES_LOADX((g + 1) & 1, g + 1);
            __builtin_amdgcn_sched_barrier(0);
            const int row = rowt + ai * HALF + m * 16;
            const size_t ro = (size_t)row * DM + colb;
            float ss = 0.f;
#pragma unroll
            for (int bj = 0; bj < 2; ++bj) {
                f32x4 xs[2], xn[2];
                if constexpr (SRC_BF16) { const u32x4 w = raw[g & 1][bj];
                    xs[0] = (f32x4){bf_lo(w.x), bf_hi(w.x), bf_lo(w.y), bf_hi(w.y)} * giv[bj][0]; xs[1] = (f32x4){bf_lo(w.z), bf_hi(w.z), bf_lo(w.w), bf_hi(w.w)} * giv[bj][1]; }
                else { xs[0] = __builtin_bit_cast(f32x4, raw[g & 1][bj * 2]); xs[1] = __builtin_bit_cast(f32x4, raw[g & 1][bj * 2 + 1]); }
#pragma unroll
                for (int n = 0; n < 2; ++n) {
                    xn[n] = xs[n] + gt[bj][n] * acc[ai][bj][m][n];
                    if (xout) *(f32x4*)(xout + ro + bj * HALF + 4 * n) = xn[n];
                    ss += (xn[n][0] * xn[n][0] + xn[n][1] * xn[n][1]) + (xn[n][2] * xn[n][2] + xn[n][3] * xn[n][3]);
                }
                if (gs) *(u32x4*)(XS + ro + bj * HALF) = pack8(xn[0] * gsv[bj][0], xn[1] * gsv[bj][1]);
            }
            if (gs) { ss = rowsum4(ss, fr, fq); if (fq == 0) SS[(size_t)row * 16 + u.pn * 4 + wc] = ss; }
            __builtin_amdgcn_sched_barrier(0);
        }
#undef RES_LOADX
    }
};

__device__ __forceinline__ float dpp_shr1(float old, float src) { return __int_as_float(__builtin_amdgcn_update_dpp(__float_as_int(old), __float_as_int(src), 0x111, 0xf, 0xf, false)); }
__device__ __forceinline__ float dpp_shr2(float old, float src) { return __int_as_float(__builtin_amdgcn_update_dpp(__float_as_int(old), __float_as_int(src), 0x112, 0xf, 0xf, false)); }
__device__ __forceinline__ float conv_taps(float c, float g0, float p, float w1, float w0) {
    asm("s_nop 1\n\tv_fmac_f32_dpp %0, %1, %3 row_shr:1 row_mask:0xf bank_mask:0xf bound_ctrl:1\n\t"
        "v_fmac_f32_dpp %0, %1, %4 row_shr:2 row_mask:0xf bank_mask:0xf bound_ctrl:1\n\t"
        "v_fmac_f32_dpp %0, %2, %3 row_shl:15 row_mask:0xf bank_mask:0xf bound_ctrl:1\n\t"
        "v_fmac_f32_dpp %0, %2, %4 row_shl:14 row_mask:0xf bank_mask:0xf bound_ctrl:1" : "+v"(c) : "v"(g0), "v"(p), "v"(w1), "v"(w0));
    return c;
}
__device__ __forceinline__ float dpp_shr1z(float src) { return __int_as_float(__builtin_amdgcn_update_dpp(0, __float_as_int(src), 0x111, 0xf, 0xf, true)); }
__device__ __forceinline__ float dpp_shr2z(float src) { return __int_as_float(__builtin_amdgcn_update_dpp(0, __float_as_int(src), 0x112, 0xf, 0xf, true)); }
__device__ __forceinline__ float dpp_ror1(float src) { return __int_as_float(__builtin_amdgcn_update_dpp(0, __float_as_int(src), 0x121, 0xf, 0xf, false)); }
__device__ __forceinline__ float dpp_ror2(float src) { return __int_as_float(__builtin_amdgcn_update_dpp(0, __float_as_int(src), 0x122, 0xf, 0xf, false)); }

struct EpiFfnIn {
    static constexpr bool PERM = true, AFTER_DRAIN = false, MIDK = false;
    bf16_t* ACT; float* side; float* out; const float* cw; const float* cb; const float* cc; PG8_LAS float* halo; const PG8_LAS float* rtab; const PG8_LAS float* ev; const float* cv; int layer;
    __device__ __forceinline__ void operator()(const f32x4 (&acc)[2][2][4][2], const Unit& u, int wr, int wc, int fr, int fq) const {
        const bool smp = u.pm >= 64;
        const int rowt = u.pm * BM + wr * 64 + fr, ch = u.pn * HALF + 32 * wc + 8 * fq;
        const int hj = fr >= 14 ? fr - 14 : 0;
        f32x4 cgv[2], cuv[2];
        f32x4 w0[2], w1[2], w2[2], bb[2];
#pragma unroll
        for (int n = 0; n < 2; ++n) { const PG8_LAS float* ep = ev + u.ui * 768 + 256 + 32 * wc + 8 * fq + 4 * n;
            w0[n] = *(const PG8_LAS f32x4*)ep; w1[n] = *(const PG8_LAS f32x4*)(ep + 128); w2[n] = *(const PG8_LAS f32x4*)(ep + 256); bb[n] = *(const PG8_LAS f32x4*)(ep + 384); }
        if (!smp) {
            const PG8_LAS float* cp = ev + u.ui * 768 + 32 * wc + 8 * fq;
            cgv[0] = *(const PG8_LAS f32x4*)cp; cgv[1] = *(const PG8_LAS f32x4*)(cp + 4); cuv[0] = *(const PG8_LAS f32x4*)(cp + HALF); cuv[1] = *(const PG8_LAS f32x4*)(cp + HALF + 4);
            if (fr >= 14) {
#pragma unroll
                for (int ai = 0; ai < 2; ++ai) { const float rs = rtab[u.ui * 256 + ai * HALF + 48 + wr * 64 + fr];
#pragma unroll
                    for (int n = 0; n < 2; ++n) *(PG8_LAS f32x4*)(halo + ((wr * 4 + wc) * 2 + ai) * 64 + hj * 32 + fq * 8 + n * 4) = acc[ai][0][3][n] * rs + cgv[n]; }
            }
        }
        asm volatile("s_waitcnt lgkmcnt(0)" ::: "memory"); __builtin_amdgcn_s_barrier(); asm volatile("" ::: "memory");
        f32x4 pnx[2]; pnx[0] = (f32x4){0.f, 0.f, 0.f, 0.f}; pnx[1] = pnx[0];
#define FFN_SMP_LOAD(ROW_) do { const float* cp_ = cv + (size_t)(NBATCH + (((ROW_) - MP) >> 4)) * (2 * DFF) + u.pn * BM + 32 * wc + 8 * fq; \
            cgv[0] = *(const f32x4*)cp_; cgv[1] = *(const f32x4*)(cp_ + 4); cuv[0] = *(const f32x4*)(cp_ + HALF); cuv[1] = *(const f32x4*)(cp_ + HALF + 4); \
            const float* cq_ = cc + ((size_t)(((ROW_) - MP) >> 4) * 2 + hj) * DFF + ch; pnx[0] = *(const f32x4*)cq_; pnx[1] = *(const f32x4*)(cq_ + 4); } while (0)
        if (smp) FFN_SMP_LOAD(rowt);
#pragma unroll
        for (int ai = 0; ai < 2; ++ai) {
            f32x4 gp[2]; gp[0] = (f32x4){0.f, 0.f, 0.f, 0.f}; gp[1] = gp[0];
#pragma unroll
            for (int m = 0; m < 4; ++m) {
                const int row = rowt + ai * HALF + m * 16;
                const float rs = rtab[u.ui * 256 + ai * HALF + m * 16 + wr * 64 + fr];
                f32x4 gc[2], uf[2];
#pragma unroll
                for (int n = 0; n < 2; ++n) { gc[n] = acc[ai][0][m][n] * rs + cgv[n]; uf[n] = acc[ai][1][m][n] * rs + cuv[n]; }
                f32x4 pv[2]; pv[0] = gp[0]; pv[1] = gp[1];
                if (smp) { pv[0] = pnx[0]; pv[1] = pnx[1];
                    if (ai * 4 + m + 1 < 8) { const int gn = ai * 4 + m + 1, rown = rowt + (gn >> 2) * HALF + (gn & 3) * 16; FFN_SMP_LOAD(rown); } }
                else if (m == 0 && (ai == 1 || wr == 1)) { const PG8_LAS float* hp = halo + (((wr ^ 1) * 4 + wc) * 2 + (wr ? ai : 0)) * 64 + hj * 32 + fq * 8; pv[0] = *(const PG8_LAS f32x4*)hp; pv[1] = *(const PG8_LAS f32x4*)(hp + 4); }
                f32x4 y[2];
#pragma unroll
                for (int n = 0; n < 2; ++n)
#pragma unroll
                    for (int e = 0; e < 4; ++e) {
                        const float g0 = gc[n][e], p = pv[n][e];
                        const float c = conv_taps(__builtin_fmaf(w2[n][e], g0, bb[n][e]), g0, p, w1[n][e], w0[n][e]);
                        y[n][e] = gelu_tanh(c) * uf[n][e];
                    }
                *(u32x4*)(ACT + (size_t)row * DFF + ch) = pack8(y[0], y[1]);
                if (smp) { if (fr >= 14) { float* fo = out + O_CS + ((size_t)(layer * DECB + ((row - MP) >> 4)) * 2 + hj) * DFF + ch; *(f32x4*)fo = gc[0]; *(f32x4*)(fo + 4) = gc[1]; } }
                else {
                    if (ai == 1 && m == 3 && wr == 1 && fr >= 14) { float* gh = side + ((size_t)u.pm * 2 + hj) * DFF + ch; *(f32x4*)gh = gc[0]; *(f32x4*)(gh + 4) = gc[1];
                        if ((u.pm & 31) == 31) { float* fo = out + O_CP + ((size_t)(layer * NBATCH + (u.pm >> 5)) * 2 + hj) * DFF + ch; *(f32x4*)fo = gc[0]; *(f32x4*)(fo + 4) = gc[1]; } }
                    if (ai == 0 && m == 0 && wr == 0 && fr < 2 && (u.pm & 31) != 0) { float* fx = side + SIDE_N + ((size_t)u.pm * 2 + fr) * DFF + ch;
                        *(f32x4*)fx = gc[0]; *(f32x4*)(fx + 4) = gc[1]; *(f32x4*)(fx + SIDE_N) = uf[0]; *(f32x4*)(fx + SIDE_N + 4) = uf[1]; }
                }
                gp[0] = gc[0]; gp[1] = gc[1];
                asm volatile("" ::: "memory");
            }
        }
    }
#undef FFN_SMP_LOAD
};

template <class Epi, class Sched, bool ALIGN_EPI = false, bool SP2 = false, class Strip = NoStrip, class Pre = NoPre, bool ASMDMA = false, bool DMA_FIRST = false>
__device__ __forceinline__ void gemm_phase(PG8_LAS unsigned char* lds, const Gemm g, const Sched& S, const Epi& E, const Strip& Z = Strip(), const Pre& pre = Pre()) {
    static_assert(!Strip::ON || (SP2 && Epi::PERM), "the strip rides on the SP2 schedule");
    int tid_o = threadIdx.x; asm volatile("" : "+v"(tid_o));
    const int tid = tid_o, wid = __builtin_amdgcn_readfirstlane(tid >> 6), lane = tid & 63, wr = wid >> 2, wc = wid & 3, fr = lane & 15, fq = lane >> 4;
    const int K = g.K, nt = K / BK;
    unsigned voffA[2], voffB[2];
#pragma unroll
    for (int i = 0; i < 2; ++i) { int R, C; stage_rc(tid * 16 + i * 8192, R, C); const int Rb = Epi::PERM ? ((R & ~31) + perm32(R & 31)) : R;
        voffA[i] = (unsigned)(R * K + C) * 2u; voffB[i] = (unsigned)(Rb * K + C) * 2u; }
    const unsigned ldsb = (unsigned)(uintptr_t)lds;
    const size_t kstep = (size_t)(BK * 2);
    const size_t hstep = (size_t)HALF * K * 2;
    const size_t tstep = 2 * hstep;
    const unsigned ldsw = (unsigned)wid * 1024u;
    const int aoff = lds_byte(wr * 64 + fr, fq * 8), boff = lds_byte(wc * 32 + fr, fq * 8);
#define PG8_SA(b, h) (((b) * 2 + (h)) * HTB)
#define PG8_SB(b, h) ((4 + (b) * 2 + (h)) * HTB)
#define PG8_STAGE(bufoff, gbase, voff) do { _Pragma("unroll") for (int _i = 0; _i < 2; ++_i) \
        { if constexpr (ASMDMA) { asm volatile("s_mov_b32 m0, %2\n\ts_nop 0\n\tglobal_load_lds_dwordx4 %0, %1" :: "v"((voff)[_i]), "s"((const char*)(gbase)), "s"(ldsb + (unsigned)(bufoff) + ldsw + (unsigned)_i * 8192u) : "memory", "m0"); } else __builtin_amdgcn_global_load_lds((const unsigned*)((const char*)(gbase) + (voff)[_i]), (PG8_LAS unsigned*)(lds + (bufoff) + ldsw + _i * 8192), 16, 0, 0); } } while (0)
#define PG8_LDA(dst, b, h) do { _Pragma("unroll") for (int m = 0; m < 4; ++m) _Pragma("unroll") for (int k = 0; k < 2; ++k) dst[m][k] = *(const PG8_LAS bf16x8*)(lds + PG8_SA(b, h) + aoff + m * 2048 + k * 1024); } while (0)
#define PG8_LDB(dst, b, h) do { _Pragma("unroll") for (int n = 0; n < 2; ++n) _Pragma("unroll") for (int k = 0; k < 2; ++k) dst[n][k] = *(const PG8_LAS bf16x8*)(lds + PG8_SB(b, h) + boff + n * 2048 + k * 1024); } while (0)
#ifndef PG8_PRIO
#define PG8_PRIO 1
#endif
#define PG8_MMA(ai, bj, At, Bt) do { __builtin_amdgcn_s_setprio(PG8_PRIO); _Pragma("unroll") for (int m = 0; m < 4; ++m) _Pragma("unroll") for (int n = 0; n < 2; ++n) _Pragma("unroll") for (int k = 0; k < 2; ++k) \
        acc[ai][bj][m][n] = __builtin_amdgcn_mfma_f32_16x16x32_bf16(Bt[n][k], At[m][k], acc[ai][bj][m][n], 0, 0, 0); __builtin_amdgcn_s_setprio(0); } while (0)
#define PG8_WAIT_V(n) asm volatile("s_waitcnt vmcnt(" #n ")" ::: "memory")
#define PG8_WAIT_VS(n, ns) do { if constexpr (Strip::ON) PG8_WAIT_V(ns); else PG8_WAIT_V(n); } while (0)
    const unsigned zoff = Strip::ON ? ((unsigned)((2 * wid + ((lane >> 3) & 1)) * K) + (unsigned)(((lane & 7) ^ wid) * 8)) * 2u : 0u;
    const int zrd0 = (fr * 8 + (fq ^ (fr >> 1))) * 16, zrd1 = (fr * 8 + ((4 + fq) ^ (fr >> 1))) * 16;
#define PG8_ZSTAGE(b, gz) do { if constexpr (Strip::ON) { if (lane < 16) __builtin_amdgcn_global_load_lds((const unsigned*)((gz) + zoff), (PG8_LAS unsigned*)(lds + STAGE_BYTES + (b) * 2048 + wid * 256), 16, 0, 0); } } while (0)
#define PG8_LDZ(b) do { if constexpr (Strip::ON) { Ax[0] = *(const PG8_LAS bf16x8*)(lds + STAGE_BYTES + (b) * 2048 + zrd0); Ax[1] = *(const PG8_LAS bf16x8*)(lds + STAGE_BYTES + (b) * 2048 + zrd1); } } while (0)
#define PG8_ZM2(Bx, n_) do { accx = __builtin_amdgcn_mfma_f32_16x16x32_bf16(Bx[n_][0], Ax[0], accx, 0, 0, 0); accx = __builtin_amdgcn_mfma_f32_16x16x32_bf16(Bx[n_][1], Ax[1], accx, 0, 0, 0); } while (0)
#define PG8_ZMMA() do { if constexpr (Strip::ON) { if (zh) { if (wr) PG8_ZM2(B1, 1); else PG8_ZM2(B1, 0); } else { if (wr) PG8_ZM2(B0, 1); else PG8_ZM2(B0, 0); } } } while (0)
#define PG8_WAIT_L(n) asm volatile("s_waitcnt lgkmcnt(" #n ")" ::: "memory")
#define PG8_BAR __builtin_amdgcn_s_barrier()
#define PG8_SCHED __builtin_amdgcn_sched_barrier(0)
    Unit cur, nxt; int ui = 0;
    if (!S.next(0, cur)) return;
    f32x4 acc[2][2][4][2];
#pragma unroll
    for (int a = 0; a < 2; ++a)
#pragma unroll
        for (int b = 0; b < 2; ++b)
#pragma unroll
            for (int m = 0; m < 4; ++m)
#pragma unroll
                for (int n = 0; n < 2; ++n) acc[a][b][m][n] = (f32x4){0.f, 0.f, 0.f, 0.f};
    bf16x8 At[4][2], B0[2][2], B1[2][2];
    f32x4 accx = (f32x4){0.f, 0.f, 0.f, 0.f}; bf16x8 Ax[2]; (void)Ax; (void)accx;
    const size_t zstep = (size_t)16 * K * 2;
    const char* cZ = nullptr; bool zh = false; (void)zh;
    if constexpr (Strip::ON) { cZ = (const char*)Z.zA + (size_t)(cur.pm >> 1) * zstep; zh = (cur.pm & 1) != 0; }
    const char* cA = (const char*)g.A + (size_t)cur.pm * tstep; const char* cB = (const char*)g.Bt + (size_t)cur.pn * tstep;
    S.a_ready(cur);
    if constexpr (SP2) {
        PG8_STAGE(PG8_SB(0, 0), cB, voffB); PG8_STAGE(PG8_SB(0, 1), cB + hstep, voffB); PG8_STAGE(PG8_SA(0, 0), cA, voffA); PG8_STAGE(PG8_SA(0, 1), cA + hstep, voffA); PG8_ZSTAGE(0, cZ);
        pre();
        if (wr == 1) PG8_BAR;
        PG8_WAIT_VS(2, 3); PG8_BAR;
        PG8_STAGE(PG8_SB(1, 0), cB + kstep, voffB); PG8_STAGE(PG8_SA(1, 0), cA + kstep, voffA); PG8_STAGE(PG8_SB(1, 1), cB + hstep + kstep, voffB);
        PG8_WAIT_V(6); PG8_BAR;
    } else {
        PG8_STAGE(PG8_SB(0, 0), cB, voffB); PG8_STAGE(PG8_SA(0, 0), cA, voffA); PG8_STAGE(PG8_SB(0, 1), cB + hstep, voffB); PG8_STAGE(PG8_SA(0, 1), cA + hstep, voffA);
        if (wr == 1) PG8_BAR;
        PG8_WAIT_V(4); PG8_BAR;
        PG8_STAGE(PG8_SB(1, 0), cB + kstep, voffB); PG8_STAGE(PG8_SA(1, 0), cA + kstep, voffA); PG8_STAGE(PG8_SB(1, 1), cB + hstep + kstep, voffB);
        PG8_WAIT_V(6); PG8_BAR;
    }
    for (;;) {
        const bool has_next = S.next(ui + 1, nxt);
        const char* nA = has_next ? (const char*)g.A + (size_t)nxt.pm * tstep : cA; const char* nB = has_next ? (const char*)g.Bt + (size_t)nxt.pn * tstep : cB;
        const char* nZ = cZ; if constexpr (Strip::ON) { if (has_next) nZ = (const char*)Z.zA + (size_t)(nxt.pm >> 1) * zstep; }
        for (int t = 0; t < nt; t += 2) {
            const bool last = (t == nt - 2);
            const char* a1 = cA + (size_t)(t + 1) * kstep;
            const char* a2 = last ? nA : cA + (size_t)(t + 2) * kstep; const char* b2 = last ? nB : cB + (size_t)(t + 2) * kstep;
            const char* a3 = a2 + kstep; const char* b3 = b2 + kstep;
            if (last && has_next) S.a_ready(nxt);
            if constexpr (Epi::MIDK) { if (t == (nt >> 1)) { if constexpr (Strip::ON) { const auto zg = Z.mid_load(cur, wr, wc, fr, fq); E.mid(acc, cur, wr, wc, fr, fq); Z.mid_apply(accx, zg); } else E.mid(acc, cur, wr, wc, fr, fq); } }
            const char* z1 = cZ + (size_t)(t + 1) * kstep; const char* z2 = last ? nZ : cZ + (size_t)(t + 2) * kstep; (void)z1; (void)z2;
            if constexpr (SP2) {
            if constexpr (DMA_FIRST) { PG8_STAGE(PG8_SA(1, 1), a1 + hstep, voffA); PG8_ZSTAGE(1, z1); PG8_SCHED; PG8_LDB(B0, 0, 0); PG8_LDB(B1, 0, 1); PG8_SCHED; PG8_LDA(At, 0, 0); } else {
            PG8_LDB(B0, 0, 0); PG8_LDB(B1, 0, 1); PG8_SCHED; PG8_LDA(At, 0, 0); PG8_STAGE(PG8_SA(1, 1), a1 + hstep, voffA); PG8_ZSTAGE(1, z1); }
            PG8_WAIT_VS(8, 9); PG8_WAIT_L(0); PG8_BAR; PG8_MMA(0, 0, At, B0); PG8_MMA(0, 1, At, B1); PG8_BAR; PG8_SCHED;
            if constexpr (DMA_FIRST) { PG8_STAGE(PG8_SB(0, 0), b2, voffB); PG8_STAGE(PG8_SB(0, 1), b2 + hstep, voffB); PG8_STAGE(PG8_SA(0, 0), a2, voffA); PG8_SCHED; PG8_LDA(At, 0, 1); PG8_LDZ(0); } else {
            PG8_LDA(At, 0, 1); PG8_LDZ(0); PG8_STAGE(PG8_SB(0, 0), b2, voffB); PG8_STAGE(PG8_SB(0, 1), b2 + hstep, voffB); PG8_STAGE(PG8_SA(0, 0), a2, voffA); }
            PG8_WAIT_VS(8, 9); PG8_WAIT_L(0); PG8_BAR; PG8_MMA(1, 0, At, B0); PG8_MMA(1, 1, At, B1); PG8_ZMMA(); PG8_BAR; PG8_SCHED;
            if constexpr (DMA_FIRST) { PG8_STAGE(PG8_SA(0, 1), a2 + hstep, voffA); PG8_ZSTAGE(0, z2); PG8_SCHED; PG8_LDB(B0, 1, 0); PG8_LDB(B1, 1, 1); PG8_SCHED; PG8_LDA(At, 1, 0); } else {
            PG8_LDB(B0, 1, 0); PG8_LDB(B1, 1, 1); PG8_SCHED; PG8_LDA(At, 1, 0); PG8_STAGE(PG8_SA(0, 1), a2 + hstep, voffA); PG8_ZSTAGE(0, z2); }
            PG8_WAIT_VS(8, 9); PG8_WAIT_L(0); PG8_BAR; PG8_MMA(0, 0, At, B0); PG8_MMA(0, 1, At, B1); PG8_BAR; PG8_SCHED;
            if constexpr (DMA_FIRST) { PG8_STAGE(PG8_SB(1, 0), b3, voffB); PG8_STAGE(PG8_SB(1, 1), b3 + hstep, voffB); PG8_STAGE(PG8_SA(1, 0), a3, voffA); PG8_SCHED; PG8_LDA(At, 1, 1); PG8_LDZ(1); } else {
            PG8_LDA(At, 1, 1); PG8_LDZ(1); PG8_STAGE(PG8_SB(1, 0), b3, voffB); PG8_STAGE(PG8_SB(1, 1), b3 + hstep, voffB); PG8_STAGE(PG8_SA(1, 0), a3, voffA); }
            PG8_WAIT_VS(8, 9); PG8_WAIT_L(0); PG8_BAR; PG8_MMA(1, 0, At, B0); PG8_MMA(1, 1, At, B1); PG8_ZMMA(); PG8_BAR; PG8_SCHED;
            } else {
            PG8_LDB(B0, 0, 0); PG8_SCHED; PG8_LDA(At, 0, 0); PG8_STAGE(PG8_SA(1, 1), a1 + hstep, voffA);
            PG8_WAIT_L(8); PG8_BAR; PG8_WAIT_L(0); PG8_MMA(0, 0, At, B0); PG8_BAR; PG8_SCHED;
            PG8_LDB(B1, 0, 1); PG8_STAGE(PG8_SB(0, 0), b2, voffB);
            PG8_BAR; PG8_WAIT_L(0); PG8_MMA(0, 1, At, B1); PG8_BAR;
            PG8_LDA(At, 0, 1); PG8_STAGE(PG8_SA(0, 0), a2, voffA);
            PG8_BAR; PG8_WAIT_L(0); PG8_MMA(1, 0, At, B0); PG8_BAR; PG8_SCHED;
            PG8_STAGE(PG8_SB(0, 1), b2 + hstep, voffB);
            PG8_WAIT_V(6); PG8_BAR; PG8_MMA(1, 1, At, B1); PG8_BAR;
            PG8_LDB(B0, 1, 0); PG8_SCHED; PG8_LDA(At, 1, 0); PG8_STAGE(PG8_SA(0, 1), a2 + hstep, voffA);
            PG8_WAIT_L(8); PG8_BAR; PG8_WAIT_L(0); PG8_MMA(0, 0, At, B0); PG8_BAR; PG8_SCHED;
            PG8_LDB(B1, 1, 1); PG8_STAGE(PG8_SB(1, 0), b3, voffB);
            PG8_BAR; PG8_WAIT_L(0); PG8_MMA(0, 1, At, B1); PG8_BAR;
            PG8_LDA(At, 1, 1); PG8_STAGE(PG8_SA(1, 0), a3, voffA);
            PG8_BAR; PG8_WAIT_L(0); PG8_MMA(1, 0, At, B0); PG8_BAR; PG8_SCHED;
            PG8_STAGE(PG8_SB(1, 1), b3 + hstep, voffB);
            PG8_WAIT_V(6); PG8_BAR; PG8_MMA(1, 1, At, B1); PG8_BAR;
            }
        }
        if constexpr (ALIGN_EPI) { if (wr == 0) PG8_BAR; }
        if constexpr (Strip::ON && !Strip::LATE) { Z.fin(accx, cur, wr, wc, fr, fq, lds + STAGE_BYTES + 4096, wid); accx = (f32x4){0.f, 0.f, 0.f, 0.f}; }
        if constexpr (Strip::ON && Strip::LATE) { const auto zf = Z.fin_load(cur, wr, wc, fr, fq); if constexpr (!Epi::AFTER_DRAIN) { E(acc, cur, wr, wc, fr, fq); S.done(cur); } Z.fin_apply(accx, zf, cur, wr, wc, fr, fq, lds + STAGE_BYTES + 4096, wid); accx = (f32x4){0.f, 0.f, 0.f, 0.f}; }
        else if constexpr (!Epi::AFTER_DRAIN) { E(acc, cur, wr, wc, fr, fq); S.done(cur); }
        if constexpr (Strip::ON) Z.post(cur, fr, fq, lds + STAGE_BYTES + 4096, wid);
        if (!has_next) break;
#pragma unroll
        for (int a = 0; a < 2; ++a)
#pragma unroll
            for (int b = 0; b < 2; ++b)
#pragma unroll
                for (int m = 0; m < 4; ++m)
#pragma unroll
                    for (int n = 0; n < 2; ++n) acc[a][b][m][n] = (f32x4){0.f, 0.f, 0.f, 0.f};
        cur = nxt; cA = nA; cB = nB; ++ui; if constexpr (Strip::ON) { cZ = nZ; zh = (cur.pm & 1) != 0; }
        if constexpr (ALIGN_EPI) { if (wr == 1) PG8_BAR; }
    }
    PG8_WAIT_V(0);
    if constexpr (!ALIGN_EPI) { if (wr == 0) PG8_BAR; }
    PG8_BAR;
    if constexpr (Epi::AFTER_DRAIN) { E.fused(acc, cur, wr, wc, fr, fq, lds, wid, lane); S.done(cur); }
#undef PG8_SA
#undef PG8_SB
#undef PG8_STAGE
#undef PG8_LDA
#undef PG8_LDB
#undef PG8_MMA
#undef PG8_WAIT_V
#undef PG8_WAIT_VS
#undef PG8_ZSTAGE
#undef PG8_LDZ
#undef PG8_ZMMA
#undef PG8_ZM2
#undef PG8_WAIT_L
#undef PG8_BAR
#undef PG8_SCHED
}
}
#define GAS __attribute__((address_space(1)))
#define LAS __attribute__((address_space(3)))
typedef unsigned short bf16;
typedef unsigned v4u __attribute__((ext_vector_type(4)));
typedef float f32x4 __attribute__((ext_vector_type(4)));
typedef short bf16x8 __attribute__((ext_vector_type(8)));
typedef GAS unsigned gu32;
typedef GAS unsigned long long gu64;
#define RLX_AGENT __ATOMIC_RELAXED, __HIP_MEMORY_SCOPE_AGENT
#define LDS_WAIT() asm volatile("s_waitcnt lgkmcnt(0)" ::: "memory")
#define VM_WAIT() asm volatile("s_waitcnt vmcnt(0)" ::: "memory")
__device__ __forceinline__ unsigned long long rt() { return __builtin_amdgcn_s_memrealtime(); }
__device__ __forceinline__ unsigned f2bf(float f) { unsigned u = __builtin_bit_cast(unsigned, f); return (u + 0x7fffu + ((u >> 16) & 1u)) >> 16; }
__device__ __forceinline__ unsigned pk2(float lo, float hi) { return f2bf(lo) | (f2bf(hi) << 16); }

#define XB_TMO      128
#define XB_XCNT(j)  (256  + 64 * (j))
#define XB_XSUB(j)  (1280 + 64 * (j))
#define XB_XGEN(j)  (2304 + 64 * (j))
#define XB_TOP      3328
#define XB_TOPGEN   3392
#define XCD_BAR_WORDS 3456
#define XB_SPIN_CAP (1u << 18)

__device__ __forceinline__ unsigned xb_ld(unsigned* p)              { return __hip_atomic_load(p, __ATOMIC_RELAXED, __HIP_MEMORY_SCOPE_AGENT); }
__device__ __forceinline__ unsigned xb_add(unsigned* p, unsigned v) { return __hip_atomic_fetch_add(p, v, __ATOMIC_RELAXED, __HIP_MEMORY_SCOPE_AGENT); }
__device__ __forceinline__ unsigned xb_xcc_id() { return (unsigned)__builtin_amdgcn_s_getreg((3 << 11) | 20) & 0xFu; }
#define XB_SPIN(cond, bar) do { unsigned _sp = 0; while (cond) { __builtin_amdgcn_s_sleep(1); \
    if ((++_sp & 255u) == 0u) { if (xb_ld(&(bar)[XB_TMO])) break; if (_sp > XB_SPIN_CAP) { atomicAdd(&(bar)[XB_TMO], 1u); break; } } } } while (0)

struct XcdBarrier {
    unsigned* bar; unsigned x;
    volatile LAS unsigned* st;
};

__device__ __forceinline__ XcdBarrier xcd_barrier_post(unsigned* bar, volatile LAS unsigned* st) {
    XcdBarrier b; b.bar = bar; b.x = xb_xcc_id(); b.st = st;
    if (threadIdx.x == 0) (void)xb_add(&bar[XB_XCNT(b.x)], 1u);
    return b;
}
__device__ __forceinline__ void xcd_barrier_complete(unsigned* bar, unsigned x, unsigned& nloc, unsigned& nx) {
    const unsigned G = gridDim.x * gridDim.y * gridDim.z;
    unsigned sum, cnt, mine, sp = 0u;
    for (;;) {
        sum = 0u; cnt = 0u; mine = 0u;
        unsigned cv[16];
#pragma unroll
        for (unsigned j = 0; j < 16; ++j) asm volatile("global_load_dword %0, %1, off sc1" : "=v"(cv[j]) : "v"(&bar[XB_XCNT(j)]) : "memory");
        asm volatile("s_waitcnt vmcnt(0)" ::: "memory");
#pragma unroll
        for (unsigned j = 0; j < 16; ++j) { unsigned c = cv[j]; asm volatile("" : "+v"(c)); sum += c; cnt |= (c > 0u) ? (1u << j) : 0u; mine = (j == x) ? c : mine; }
        if (sum == G) break;
        __builtin_amdgcn_s_sleep(1);
        if ((++sp & 255u) == 0u) { if (xb_ld(&bar[XB_TMO])) break; if (sp > XB_SPIN_CAP) { atomicAdd(&bar[XB_TMO], 1u); break; } }
    }
    nloc = mine > 0u ? mine : 1u; nx = cnt != 0u ? cnt : (1u << x);
}

#define XB_FLAGS 3520
__device__ __forceinline__ void xcd_barrier(const XcdBarrier& b) {
    asm volatile("s_waitcnt vmcnt(0)" ::: "memory");
    __syncthreads();
    if (threadIdx.x < 16) {
        unsigned* bar = b.bar; unsigned ln = threadIdx.x; asm volatile("" : "+v"(ln));
        if (ln == 0) {
            __builtin_amdgcn_s_waitcnt(0);
            unsigned nloc = b.st[0], msk = b.st[1];
            if (nloc == 0u) { xcd_barrier_complete(bar, b.x, nloc, msk); b.st[0] = nloc; b.st[1] = msk; }
            const unsigned gen = b.st[2] + 1u; b.st[2] = gen;
            const unsigned old = xb_add(&bar[XB_XSUB(b.x)], 1u);
            if (old + 1u == gen * nloc) {
                __builtin_amdgcn_fence(__ATOMIC_RELEASE, "agent");
                asm volatile("s_waitcnt vmcnt(0)" ::: "memory");
                (void)xb_add(&bar[XB_FLAGS + b.x], 1u);
            }
        }
        asm volatile("s_waitcnt lgkmcnt(0)" ::: "memory");
        const unsigned gen = b.st[2], msk = b.st[1];
        const bool need = ((msk >> ln) & 1u) != 0u;
        unsigned sp = 0u;
        for (;;) {
            const unsigned f = xb_ld(&bar[XB_FLAGS + ln]);
            if (!__any(need && f < gen)) break;
            if ((++sp & 255u) == 0u) { if (xb_ld(&bar[XB_TMO])) break; if (sp > XB_SPIN_CAP) { if (ln == 0) atomicAdd(&bar[XB_TMO], 1u); break; } }
        }
        __builtin_amdgcn_fence(__ATOMIC_ACQUIRE, "agent");
        asm volatile("s_waitcnt vmcnt(0)" ::: "memory");
    }
    __syncthreads();
}

constexpr int NWAVES = 8;
typedef float f32x16 __attribute__((ext_vector_type(16)));
typedef short s16x4 __attribute__((ext_vector_type(4)));
typedef unsigned u32x2 __attribute__((ext_vector_type(2)));

constexpr int RING_BYTES = 131072;
constexpr int LDSCTL_OFF = 159744, MISC_OFF = LDSCTL_OFF + 320;
constexpr int LDS_BYTES = 163840;

struct Args { const float* in[25]; float* out; unsigned char* ws; int ph_lo, ph_hi; };
static_assert(sizeof(Args) == 25 * 8 + 8 + 8 + 8, "Args has no padding");
struct Frame {
    LAS unsigned char* lds;
    volatile LAS unsigned* MISC;
    gu32* ctl;
    int tid, lane, wave, vcu, G;
    float* out; unsigned char* ws;
};
#define F_IN_XP 0
#define F_IN_XS 1
#define F_IN_CK 2
#define F_IN_CV 3
#define F_IN_CC 4
#define F_IN_CP 5
#define F_IN_CSM 6
#define F_IN_N1 7
#define F_IN_N2 8
#define F_IN_WADA 9
#define F_IN_BADA 10
#define F_IN_WIN 11
#define F_IN_QG 12
#define F_IN_KG 13
#define F_IN_RB 14
#define F_IN_VG 15
#define F_IN_WSP 16
#define F_IN_BSP 17
#define F_IN_WOA 18
#define F_IN_WOB 19
#define F_IN_WO 20
#define F_IN_WF1 21
#define F_IN_CW 22
#define F_IN_CB 23
#define F_IN_WF2 24

__device__ __forceinline__ float shx_(float v, int lane, int m) { return __builtin_bit_cast(float, __builtin_amdgcn_ds_bpermute((lane ^ m) << 2, __builtin_bit_cast(int, v))); }
__device__ __forceinline__ float xadd1(float v, int lane) { return v + shx_(v, lane, 1); }
__device__ __forceinline__ float wave_sum(float v, int lane) {
#pragma unroll
    for (int o = 1; o < 64; o <<= 1) v += shx_(v, lane, o);
    return v;
}
__device__ __forceinline__ unsigned cvtpk(float lo, float hi) { unsigned r; asm volatile("v_cvt_pk_bf16_f32 %0, %1, %2" : "=v"(r) : "v"(lo), "v"(hi)); return r; }
__device__ __forceinline__ float bflo(unsigned w) { return __uint_as_float(w << 16); }
__device__ __forceinline__ float bfhi(unsigned w) { return __uint_as_float(w & 0xffff0000u); }
__device__ __forceinline__ float gelu_t(float x) { const float u = x * (0.7978845608028654f + 0.035677408136300125f * x * x); return x * __builtin_amdgcn_rcpf(1.0f + __builtin_amdgcn_exp2f(-2.0f * LOG2E * u)); }

__device__ __forceinline__ void p0_transpose_item(const float* W, int ldw, int k0, int n0, bf16* WT, int ldk, int koff, int drow, LAS float* scr, int lane) {
    float v[32];
#pragma unroll
    for (int i = 0; i < 32; ++i) v[i] = W[(size_t)(k0 + 2 * i + (lane >> 5)) * ldw + n0 + (lane & 31)];
#pragma unroll
    for (int i = 0; i < 32; ++i) scr[(2 * i + (lane >> 5)) * 33 + (lane & 31)] = v[i];
    LDS_WAIT(); asm volatile("" ::: "memory");
    const int c = lane & 7;
#pragma unroll
    for (int j = 0; j < 4; ++j) { const int n = (lane >> 3) + 8 * j; const LAS float* s = scr + (8 * c) * 33 + n;
        v4u o; o.x = pk2(s[0 * 33], s[1 * 33]); o.y = pk2(s[2 * 33], s[3 * 33]); o.z = pk2(s[4 * 33], s[5 * 33]); o.w = pk2(s[6 * 33], s[7 * 33]);
        *(GAS v4u*)(WT + (size_t)(drow + n) * ldk + koff + k0 + 8 * c) = o; }
    LDS_WAIT(); asm volatile("" ::: "memory");
}
__device__ __forceinline__ int win_drow(int n0) {
    if (n0 < 2560) { const int tile = n0 >> 8, c = n0 & 255; return tile * 256 + 128 * ((c >> 5) & 1) + 32 * (c >> 6); }
    const int r = n0 - 2560, bj = r >> 10, ch = r & 1023; return 2560 + 256 * (ch >> 7) + 128 * bj + (ch & 127);
}
__device__ __forceinline__ int wf1_drow(int n0) { const int bj = n0 >= DFF ? 1 : 0, ch = n0 - bj * DFF; return 256 * (ch >> 7) + 128 * bj + (ch & 127); }

constexpr int CV_I_IN = (DM / 64) * (DIN / 32), CV_I_OA = (DA / 64) * (DM / 32), CV_I_O = (DM / 64) * (DM / 32), CV_I_F1 = (DM / 64) * (2 * DFF / 32), CV_I_F2 = (DFF / 64) * (DM / 32);
constexpr int CV_PER_L = CV_I_IN + 2 * CV_I_OA + CV_I_O + CV_I_F1 + CV_I_F2;
__device__ __forceinline__ void convert_items(Frame& F, const Args& A, int it0, int it1, int widx, int nw) {
    LAS float* scr = (LAS float*)(F.lds + F.wave * 16384);
    int lane_ = F.lane; asm volatile("" : "+v"(lane_));
    constexpr int I_IN = CV_I_IN, I_OA = CV_I_OA, I_OB = CV_I_OA, I_O = CV_I_O, I_F1 = CV_I_F1, PER_L = CV_PER_L;
    for (int it = it0 + widx * NWAVES + F.wave; it < it1; it += nw * NWAVES) {
        const int l = it / PER_L; int r = it % PER_L;
        bf16* wl = (bf16*)(F.ws + WS_W + (size_t)l * W_LAYER);
        if (r < I_IN) { const int nb = DIN / 32, k0 = 64 * (r / nb), n0 = 32 * (r % nb); p0_transpose_item(A.in[F_IN_WIN] + (size_t)l * DM * DIN, DIN, k0, n0, (bf16*)((char*)wl + W_IN), DM, 0, win_drow(n0), scr, lane_); continue; } r -= I_IN;
        if (r < I_OA) { const int nb = DM / 32, k0 = 64 * (r / nb), n0 = 32 * (r % nb); p0_transpose_item(A.in[F_IN_WOA] + (size_t)l * DA * DM, DM, k0, n0, (bf16*)((char*)wl + W_AB), DM, 0, n0, scr, lane_); continue; } r -= I_OA;
        if (r < I_OB) { const int nb = DM / 32, k0 = 64 * (r / nb), n0 = 32 * (r % nb); p0_transpose_item(A.in[F_IN_WOB] + (size_t)l * DB * DM, DM, k0, n0, (bf16*)((char*)wl + W_AB), DM, DA, n0, scr, lane_); continue; } r -= I_OB;
        if (r < I_O) { const int nb = DM / 32, k0 = 64 * (r / nb), n0 = 32 * (r % nb); p0_transpose_item(A.in[F_IN_WO] + (size_t)l * DM * DM, DM, k0, n0, (bf16*)((char*)wl + W_O), DM, 0, n0, scr, lane_); continue; } r -= I_O;
        if (r < I_F1) { const int nb = 2 * DFF / 32, k0 = 64 * (r / nb), n0 = 32 * (r % nb); p0_transpose_item(A.in[F_IN_WF1] + (size_t)l * DM * 2 * DFF, 2 * DFF, k0, n0, (bf16*)((char*)wl + W_F1), DM, 0, wf1_drow(n0), scr, lane_); continue; } r -= I_F1;
        { const int nb = DM / 32, k0 = 64 * (r / nb), n0 = 32 * (r % nb); p0_transpose_item(A.in[F_IN_WF2] + (size_t)l * DFF * DM, DM, k0, n0, (bf16*)((char*)wl + W_F2), DFF, 0, n0, scr, lane_); }
    }
}
constexpr int ST_ROWB = 2064, ST_HALF = NMODB * ST_ROWB;
typedef float f32x2g __attribute__((ext_vector_type(2)));
template <bool SILU, class RowPtr> __device__ __forceinline__ void st_build(Frame& F, const RowPtr& rowptr) {
    int tid_ = F.tid; asm volatile("" : "+v"(tid_));
    __syncthreads();
    f32x2g raw[NMODB];
#pragma unroll
    for (int b = 0; b < NMODB; ++b) raw[b] = *(const f32x2g*)(rowptr(b) + 2 * tid_);
    __builtin_amdgcn_sched_barrier(0);
#pragma unroll
    for (int b = 0; b < NMODB; ++b) {
        float v0 = raw[b].x, v1 = raw[b].y;
        if (SILU) { v0 = v0 * __builtin_amdgcn_rcpf(1.0f + __builtin_amdgcn_exp2f(-LOG2E * v0)); v1 = v1 * __builtin_amdgcn_rcpf(1.0f + __builtin_amdgcn_exp2f(-LOG2E * v1)); }
        const unsigned hi = cvtpk(v0, v1), lo = cvtpk(v0 - bflo(hi), v1 - bfhi(hi));
        *(LAS unsigned*)(F.lds + b * ST_ROWB + tid_ * 4) = hi; *(LAS unsigned*)(F.lds + ST_HALF + b * ST_ROWB + tid_ * 4) = lo; }
    LDS_WAIT(); __syncthreads();
}
__device__ __forceinline__ bf16x8 st_frag(const Frame& F, int hl, int tile, int s, int r, int q) { int row = 16 * tile + r; if (row > NMODB - 1) row = NMODB - 1;
    return *(const LAS bf16x8*)(F.lds + hl * ST_HALF + row * ST_ROWB + 64 * s + 16 * q); }
__device__ __forceinline__ void skinny34_f32_task(Frame& F, const float* W, size_t ldw, const float* bias, float* out, size_t ldo, int j0, int r, int q) {
    const float* Wp = W + j0 + r + (size_t)(8 * q) * ldw;
    f32x4 acc[3]; acc[0] = (f32x4){0.f, 0.f, 0.f, 0.f}; acc[1] = acc[0]; acc[2] = acc[0];
#pragma unroll 1
    for (int s0 = 0; s0 < 32; s0 += 8) {
        float w[8][8];
#pragma unroll
        for (int i = 0; i < 8; ++i)
#pragma unroll
            for (int e = 0; e < 8; ++e) w[i][e] = Wp[(size_t)(32 * (s0 + i) + e) * ldw];
        __builtin_amdgcn_sched_barrier(0);
#pragma unroll
        for (int i = 0; i < 8; ++i) { const int s = s0 + i;
            v4u hi, lo;
            hi.x = cvtpk(w[i][0], w[i][1]); hi.y = cvtpk(w[i][2], w[i][3]); hi.z = cvtpk(w[i][4], w[i][5]); hi.w = cvtpk(w[i][6], w[i][7]);
            lo.x = cvtpk(w[i][0] - bflo(hi.x), w[i][1] - bfhi(hi.x)); lo.y = cvtpk(w[i][2] - bflo(hi.y), w[i][3] - bfhi(hi.y)); lo.z = cvtpk(w[i][4] - bflo(hi.z), w[i][5] - bfhi(hi.z)); lo.w = cvtpk(w[i][6] - bflo(hi.w), w[i][7] - bfhi(hi.w));
            const bf16x8 bh = __builtin_bit_cast(bf16x8, hi), bl = __builtin_bit_cast(bf16x8, lo);
#pragma unroll
            for (int tl = 0; tl < 3; ++tl) { const bf16x8 ah = st_frag(F, 0, tl, s, r, q), al = st_frag(F, 1, tl, s, r, q);
                acc[tl] = __builtin_amdgcn_mfma_f32_16x16x32_bf16(ah, bh, acc[tl], 0, 0, 0);
                acc[tl] = __builtin_amdgcn_mfma_f32_16x16x32_bf16(ah, bl, acc[tl], 0, 0, 0);
                acc[tl] = __builtin_amdgcn_mfma_f32_16x16x32_bf16(al, bh, acc[tl], 0, 0, 0); } }
        __builtin_amdgcn_sched_barrier(0);
    }
    const float bv = bias ? bias[j0 + r] : 0.f;
#pragma unroll
    for (int tl = 0; tl < 3; ++tl)
#pragma unroll
        for (int e = 0; e < 4; ++e) { const int b = 16 * tl + 4 * q + e; if (b < NMODB) out[(size_t)b * ldo + j0 + r] = acc[tl][e] + bv; }
}
__device__ __forceinline__ void p0_mod(Frame& F, const Args& A) {
    float* MOD = (float*)(F.ws + WS_MOD);
    const float* cp = A.in[F_IN_CP]; const float* cs = A.in[F_IN_CSM];
    st_build<true>(F, [=](int b) { return b < NBATCH ? cp + b * DM : cs + (b - NBATCH) * DM; });
    int lane_ = F.lane; asm volatile("" : "+v"(lane_)); const int r = lane_ & 15, q = lane_ >> 4;
    for (int t = F.wave * F.G + F.vcu; t < DEPTH * 384; t += F.G * NWAVES) {
        const int l = t / 384;
        skinny34_f32_task(F, A.in[F_IN_WADA] + (size_t)l * DM * 6144, 6144, A.in[F_IN_BADA] + l * 6144, MOD + (size_t)l * NMODB * 6144, 6144, (t % 384) * 16, r, q);
    }
    __syncthreads();
}
__device__ __forceinline__ void cvec_group(Frame& F, const Args& A, int l, int w2, int widx, int nw) {
    const float* MOD = (const float*)(F.ws + WS_MOD);
    const int N = w2 ? 2 * DFF : DIN;
    const float* sh = MOD + (size_t)l * NMODB * 6144 + (w2 ? 3 * DM : 0);
    st_build<false>(F, [=](int b) { return sh + (size_t)b * 6144; });
    int lane_ = F.lane; asm volatile("" : "+v"(lane_)); const int r = lane_ & 15, q = lane_ >> 4;
    for (int t = widx * NWAVES + F.wave; t < N / 16; t += nw * NWAVES) {
        const int n0 = 16 * t; int a0;
        if (!w2) { if (n0 < 2560) { const int tile = n0 >> 8, tc = n0 & 255; a0 = tile * 256 + 64 * ((tc >> 5) & 3) + 32 * (tc >> 7) + (tc & 31); }
                   else { const int tc = (n0 - 2560) & 255, i = (n0 - 2560) >> 8; a0 = 2560 + 1024 * (tc >> 7) + 128 * i + (tc & 127); } }
        else { const int tile = n0 >> 8, tc = n0 & 255; a0 = DFF * (tc >> 7) + 128 * tile + (tc & 127); }
        const float* W = w2 ? A.in[F_IN_WF1] + (size_t)l * DM * 2 * DFF : A.in[F_IN_WIN] + (size_t)l * DM * DIN;
        float* CV = (float*)(F.ws + (w2 ? WS_CV2 : WS_CV1)) + (size_t)l * NMODB * N;
        skinny34_f32_task(F, W + a0 - n0, (size_t)N, nullptr, CV, (size_t)N, n0, r, q);
    }
    __syncthreads();
}
__device__ __forceinline__ void p1_pass(Frame& F, const Args& A) {
    const float* MOD = (const float*)(F.ws + WS_MOD);
    { int lane_ = F.lane; asm volatile("" : "+v"(lane_));
      const int gw = F.vcu * NWAVES + F.wave, NGW = F.G * NWAVES;
      const float* g = A.in[F_IN_N1]; bf16* XS = (bf16*)(F.ws + WS_H); float* SS = (float*)(F.ws + WS_SS);
      f32x4 gg[4];
#pragma unroll
      for (int j = 0; j < 4; ++j) gg[j] = *((const f32x4*)g + lane_ + 64 * j);
      for (int row0 = gw; row0 < MT; row0 += 2 * NGW) {
          f32x4 v[2][4], s1[2][4]; int rw[2];
#pragma unroll
          for (int t = 0; t < 2; ++t) { int row = row0 + t * NGW; if (row >= MT) row = row0; rw[t] = row;
              const float* xr = row < MP ? A.in[F_IN_XP] + (size_t)row * DM : A.in[F_IN_XS] + (size_t)(row - MP) * DM;
              const int b = row < MP ? row / SEQ : NBATCH + ((row - MP) >> 4);
              const float* scl = MOD + (size_t)b * 6144 + DM;
#pragma unroll
              for (int j = 0; j < 4; ++j) { v[t][j] = *((const f32x4*)xr + lane_ + 64 * j); s1[t][j] = *((const f32x4*)scl + lane_ + 64 * j); } }
          __builtin_amdgcn_sched_barrier(0);
#pragma unroll
          for (int t = 0; t < 2; ++t) { const int row = rw[t]; float ss = 0.f;
#pragma unroll
              for (int j = 0; j < 4; ++j) { const f32x4 x = v[t][j]; ss += (x.x * x.x + x.y * x.y) + (x.z * x.z + x.w * x.w);
                  const f32x4 y = x * gg[j] * (s1[t][j] + 1.0f);
                  u32x2 o; o.x = cvtpk(y.x, y.y); o.y = cvtpk(y.z, y.w);
                  *((u32x2*)(XS + (size_t)row * DM) + lane_ + 64 * j) = o; }
              ss = wave_sum(ss, lane_);
              if (lane_ < 16) SS[(size_t)row * 16 + lane_] = lane_ == 0 ? ss : 0.f; }
      } }
    if (F.G == 256) { const int grp = F.vcu >> 7; cvec_group(F, A, 0, grp, F.vcu & 127, 128); }
    { float* GS = (float*)(F.ws + WS_GS); int tid_ = F.tid; asm volatile("" : "+v"(tid_)); const int gt = F.vcu * NWAVES * 64 + tid_;
      for (int i = gt; i < DEPTH * 2 * NMODB * DM; i += F.G * NWAVES * 64) { const int k = i & 1023, b = (i >> 10) % NMODB, w = ((i >> 10) / NMODB) & 1, l = (i >> 10) / (2 * NMODB);
          const float gsv_ = A.in[w ? F_IN_N2 : F_IN_N1][l * DM + k] * (1.0f + MOD[((size_t)l * NMODB + b) * 6144 + (w ? 4 : 1) * DM + k]);
          GS[i] = gsv_; ((float*)(F.ws + WS_GSI))[i] = 1.0f / gsv_; } }
}

constexpr int RTAB_OFF = RING_BYTES + 4096, MAXU = 6;
constexpr int EPIV_OFF = RTAB_OFF + MAXU * 1024, EPIV_STRIDE = 768;
static_assert(EPIV_OFF + MAXU * EPIV_STRIDE * 4 <= LDSCTL_OFF, "LDS map");
template <bool FFN, class Sched> __device__ __forceinline__ void phase_prepass(Frame& F, const Sched& S, const float* cv, int ldcv, const float* cw, const float* cb) {
    const float* SS = (const float*)(F.ws + WS_SS); LAS float* tab = (LAS float*)(F.lds + RTAB_OFF); LAS float* ev = (LAS float*)(F.lds + EPIV_OFF);
    int tid_ = F.tid; asm volatile("" : "+v"(tid_));
    const int r = tid_ >> 1;
    f32x4 a[MAXU], b[MAXU]; float c0[MAXU], c1[MAXU]; bool have[MAXU];
#pragma unroll
    for (int i = 0; i < MAXU; ++i) { pg8::Unit u; have[i] = S.next(i, u); c0[i] = 0.f; c1[i] = 0.f;
        if (have[i]) { const f32x4* sp = (const f32x4*)(SS + ((size_t)u.pm * 256 + r) * 16) + (tid_ & 1) * 2; a[i] = sp[0]; b[i] = sp[1];
            if (tid_ < 256 && u.pm < 64) c0[i] = cv[(size_t)(u.pm >> 5) * ldcv + u.pn * 256 + tid_];
            if (FFN) { const int arr = tid_ >> 7, c = tid_ & 127; c1[i] = arr < 3 ? cw[arr * DFF + u.pn * 128 + c] : cb[u.pn * 128 + c]; } }
        else { a[i] = (f32x4){0.f, 0.f, 0.f, 0.f}; b[i] = a[i]; } }
    __builtin_amdgcn_sched_barrier(0);
#pragma unroll
    for (int i = 0; i < MAXU; ++i) { const f32x4 s4 = a[i] + b[i]; float s = (s4[0] + s4[1]) + (s4[2] + s4[3]);
        s = xadd1(s, tid_ & 63);
        if (have[i]) { if (!(tid_ & 1)) tab[i * 256 + r] = __builtin_amdgcn_rsqf(s * (1.0f / DM) + EPS);
            if (tid_ < 256) ev[i * EPIV_STRIDE + tid_] = c0[i];
            if (FFN) ev[i * EPIV_STRIDE + 256 + tid_] = c1[i]; } }
    LDS_WAIT(); __syncthreads();
}
static_assert(2 * DFF == 11 * NWAVES * 64, "ffn_fixup: 11 elements per thread");
__device__ __forceinline__ void ffn_fixup(Frame& F, const Args& A, int layer, int pm) {
    if ((pm & 31) == 0) return;
    const float* side = (const float*)(F.ws + WS_ACT + A_SIDE); bf16* ACT = (bf16*)(F.ws + WS_ACT + A_ACT);
    const float* cw = A.in[F_IN_CW] + (size_t)layer * 3 * DFF; const float* cb = A.in[F_IN_CB] + (size_t)layer * DFF;
    const float* gh = side + (size_t)(pm - 1) * 2 * DFF; const float* fg = side + SIDE_N + (size_t)pm * 2 * DFF; const float* fu = fg + SIDE_N;
    int tid_ = F.tid; asm volatile("" : "+v"(tid_));
    float gm2[11], gm1[11], g0[11], uu[11], bb[11], w0[11], w1[11], w2[11];
#pragma unroll
    for (int e = 0; e < 11; ++e) { const int i = tid_ + e * (NWAVES * 64), j = i >= DFF ? 1 : 0, ch = i - j * DFF;
        gm2[e] = gh[j * DFF + ch]; gm1[e] = j ? fg[ch] : gh[DFF + ch]; g0[e] = fg[j * DFF + ch]; uu[e] = fu[j * DFF + ch]; bb[e] = cb[ch]; w0[e] = cw[ch]; w1[e] = cw[DFF + ch]; w2[e] = cw[2 * DFF + ch]; }
    __builtin_amdgcn_sched_barrier(0);
#pragma unroll
    for (int e = 0; e < 11; ++e) { const int i = tid_ + e * (NWAVES * 64), j = i >= DFF ? 1 : 0, ch = i - j * DFF;
        const float c = bb[e] + w0[e] * gm2[e] + w1[e] * gm1[e] + w2[e] * g0[e];
        ACT[((size_t)pm * 256 + j) * DFF + ch] = (bf16)(cvtpk(gelu_t(c) * uu[e], 0.f) & 0xffffu); }
}

constexpr int AT_NS = 4, AT_SLOT = 8192, AT_K = 0, AT_V = AT_NS * AT_SLOT, AT_BT = 2 * AT_NS * AT_SLOT, AT_WS = AT_BT + 1024;
__device__ __forceinline__ int crow(int r, int hi) { return (r & 3) + 8 * (r >> 2) + 4 * hi; }
typedef short v4i16_t __attribute__((ext_vector_type(4)));
__device__ __forceinline__ s16x4 vtr(const LAS unsigned char* p) { return __builtin_bit_cast(s16x4, __builtin_amdgcn_ds_read_tr16_b64_v4i16((LAS v4i16_t*)p)); }
__device__ __forceinline__ float swapmax(float m) { auto rr = __builtin_amdgcn_permlane32_swap(__float_as_uint(m), __float_as_uint(m), false, false); return fmaxf(__uint_as_float(rr[0]), __uint_as_float(rr[1])); }
__device__ __forceinline__ float swapsum(float m) { auto rr = __builtin_amdgcn_permlane32_swap(__float_as_uint(m), __float_as_uint(m), false, false); return __uint_as_float(rr[0]) + __uint_as_float(rr[1]); }


constexpr float AT_THR = 8.f;
struct AttnState { float m, l; f32x16 o[2]; f32x16 ci; int first; };
__device__ __forceinline__ void attn_init(AttnState& st, float cb) {
    st.m = 0.f; st.l = 0.f; st.o[0] = f32x16{}; st.o[1] = f32x16{}; st.first = 1;
#pragma unroll
    for (int r = 0; r < 16; ++r) st.ci[r] = cb;
}
#define MX3(a, b, c) fmaxf(fmaxf((a), (b)), (c))
__device__ __forceinline__ void attn_tile(LAS unsigned char* lds, int slot, const bf16x8 (&qr)[4], AttnState& st, int dj, int iq, int nkeys, int wave, int lane) {
    const int r32 = lane & 31, hi = lane >> 5;
    const int kbr = (int)(unsigned)(uintptr_t)(lds + AT_K + slot * AT_SLOT) + r32 * 128, kp0 = hi ^ ((r32 >> 1) & 7);
    bf16x8 kf[8];
#pragma unroll
    for (int d0 = 0; d0 < 4; ++d0) { const int kb = kbr + ((kp0 ^ (2 * d0)) << 4);
        asm volatile("ds_read_b128 %0, %1" : "=&v"(kf[2 * d0]) : "v"(kb) : "memory");
        asm volatile("ds_read_b128 %0, %1 offset:4096" : "=&v"(kf[2 * d0 + 1]) : "v"(kb) : "memory"); }
    f32x16 p0, p1;
    asm volatile("s_waitcnt lgkmcnt(6)" : "+v"(kf[0]), "+v"(kf[1]) :: "memory");
    p0 = __builtin_amdgcn_mfma_f32_32x32x16_bf16(kf[0], qr[0], st.ci, 0, 0, 0);
    p1 = __builtin_amdgcn_mfma_f32_32x32x16_bf16(kf[1], qr[0], st.ci, 0, 0, 0);
    asm volatile("s_waitcnt lgkmcnt(4)" : "+v"(kf[2]), "+v"(kf[3]) :: "memory");
    p0 = __builtin_amdgcn_mfma_f32_32x32x16_bf16(kf[2], qr[1], p0, 0, 0, 0);
    p1 = __builtin_amdgcn_mfma_f32_32x32x16_bf16(kf[3], qr[1], p1, 0, 0, 0);
    asm volatile("s_waitcnt lgkmcnt(2)" : "+v"(kf[4]), "+v"(kf[5]) :: "memory");
    p0 = __builtin_amdgcn_mfma_f32_32x32x16_bf16(kf[4], qr[2], p0, 0, 0, 0);
    p1 = __builtin_amdgcn_mfma_f32_32x32x16_bf16(kf[5], qr[2], p1, 0, 0, 0);
    asm volatile("s_waitcnt lgkmcnt(0)" : "+v"(kf[6]), "+v"(kf[7]) :: "memory");
    p0 = __builtin_amdgcn_mfma_f32_32x32x16_bf16(kf[6], qr[3], p0, 0, 0, 0);
    p1 = __builtin_amdgcn_mfma_f32_32x32x16_bf16(kf[7], qr[3], p1, 0, 0, 0);
    if (dj < 3) {
        const int ta = (int)(unsigned)(uintptr_t)(lds + AT_BT) + (dj * 64 + iq + 63 - 4 * hi - 59) * 4;
        typedef float f32x2t __attribute__((ext_vector_type(2)));
        f32x2t tq[16];
#define AT_TRD(i_, kv_) do { asm volatile("ds_read2_b32 %0, %1 offset0:%c2 offset1:%c3" : "=&v"(tq[2 * (i_)]) : "v"(ta), "i"(59 - (kv_) - 1), "i"(59 - (kv_)) : "memory"); \
                             asm volatile("ds_read2_b32 %0, %1 offset0:%c2 offset1:%c3" : "=&v"(tq[2 * (i_) + 1]) : "v"(ta), "i"(27 - (kv_) - 1), "i"(27 - (kv_)) : "memory"); } while (0)
        AT_TRD(0, 0); AT_TRD(1, 2); AT_TRD(2, 8); AT_TRD(3, 10); AT_TRD(4, 16); AT_TRD(5, 18); AT_TRD(6, 24); AT_TRD(7, 26);
#undef AT_TRD
        asm volatile("s_waitcnt lgkmcnt(0)" : "+v"(tq[0]), "+v"(tq[1]), "+v"(tq[2]), "+v"(tq[3]), "+v"(tq[4]), "+v"(tq[5]), "+v"(tq[6]), "+v"(tq[7]),
                                              "+v"(tq[8]), "+v"(tq[9]), "+v"(tq[10]), "+v"(tq[11]), "+v"(tq[12]), "+v"(tq[13]), "+v"(tq[14]), "+v"(tq[15]) :: "memory");
#pragma unroll
        for (int i = 0; i < 8; ++i) { p0[2 * i] += tq[2 * i][1]; p0[2 * i + 1] += tq[2 * i][0]; p1[2 * i] += tq[2 * i + 1][1]; p1[2 * i + 1] += tq[2 * i + 1][0]; }
    }
    if (nkeys < 64) {
#pragma unroll
        for (int r = 0; r < 16; ++r) { if (crow(r, hi) >= nkeys) p0[r] = -INFINITY; p1[r] = -INFINITY; }
    }
    float ma = MX3(p0[0], p0[1], p1[0]), mb = MX3(p0[2], p0[3], p1[1]); ma = MX3(ma, p1[2], p1[3]);
#pragma unroll
    for (int r = 4; r < 16; r += 4) { ma = MX3(ma, p0[r], p0[r + 1]); mb = MX3(mb, p0[r + 2], p0[r + 3]); ma = MX3(ma, p1[r], p1[r + 1]); mb = MX3(mb, p1[r + 2], p1[r + 3]); }
    const float mx = swapmax(fmaxf(ma, mb));
    if (st.first || __any(mx > AT_THR)) {
        const float dl = st.first ? mx : fmaxf(mx, 0.f);
        st.m += dl;
#pragma unroll
        for (int r = 0; r < 16; ++r) { p0[r] -= dl; p1[r] -= dl; st.ci[r] -= dl; }
        if (!st.first) {
            const float f = __builtin_amdgcn_exp2f(-dl);
            st.l *= f;
            LAS float* wsf = (LAS float*)(lds + AT_WS) + wave * 64;
            if (hi == 0) wsf[r32] = f;
            LDS_WAIT(); asm volatile("" ::: "memory");
#pragma unroll
            for (int r = 0; r < 16; ++r) { const float a = wsf[crow(r, hi)]; st.o[0][r] *= a; st.o[1][r] *= a; }
        }
        st.first = 0;
    }
    float rs = 0.f;
#pragma unroll
    for (int r = 0; r < 16; ++r) { p0[r] = __builtin_amdgcn_exp2f(p0[r]); p1[r] = __builtin_amdgcn_exp2f(p1[r]); rs += p0[r] + p1[r]; }
    st.l += rs;
    bf16x8 pa[4];
#pragma unroll
    for (int k = 0; k < 4; ++k) {
        v4u w;
        if (k < 2) { w.x = cvtpk(p0[8 * k + 0], p0[8 * k + 1]); w.y = cvtpk(p0[8 * k + 2], p0[8 * k + 3]); w.z = cvtpk(p0[8 * k + 4], p0[8 * k + 5]); w.w = cvtpk(p0[8 * k + 6], p0[8 * k + 7]); }
        else { const int q = k - 2; w.x = cvtpk(p1[8 * q + 0], p1[8 * q + 1]); w.y = cvtpk(p1[8 * q + 2], p1[8 * q + 3]); w.z = cvtpk(p1[8 * q + 4], p1[8 * q + 5]); w.w = cvtpk(p1[8 * q + 6], p1[8 * q + 7]); }
        pa[k] = __builtin_bit_cast(bf16x8, w);
    }
    const int vb = (int)(unsigned)(uintptr_t)(lds + AT_V + slot * AT_SLOT) + ((lane >> 4) & 1) * 32 + (lane & 3) * 8 + (4 * hi + ((lane & 15) >> 2)) * 64;
#pragma unroll
    for (int d0 = 0; d0 < 2; ++d0) { s16x4 lo[4], hh[4];
#pragma unroll
        for (int ks = 0; ks < 4; ++ks) {
            asm volatile("ds_read_b64_tr_b16 %0, %1 offset:%c2" : "=&v"(lo[ks]) : "v"(vb), "i"(d0 * 4096 + ks * 1024) : "memory");
            asm volatile("ds_read_b64_tr_b16 %0, %1 offset:%c2" : "=&v"(hh[ks]) : "v"(vb), "i"(d0 * 4096 + ks * 1024 + 512) : "memory"); }
        asm volatile("s_waitcnt lgkmcnt(0)" ::: "memory"); __builtin_amdgcn_sched_barrier(0);
#pragma unroll
        for (int ks = 0; ks < 4; ++ks) { const bf16x8 vf = (bf16x8){lo[ks][0], lo[ks][1], lo[ks][2], lo[ks][3], hh[ks][0], hh[ks][1], hh[ks][2], hh[ks][3]};
            st.o[d0] = __builtin_amdgcn_mfma_f32_32x32x16_bf16(pa[ks], vf, st.o[d0], 0, 0, 0); }
    }
}
__device__ __forceinline__ void stage_kv_bf16(LAS unsigned char* lds, int slot, const bf16* Kb, const bf16* Vb, size_t row0, int nvalid, int h, int wave, int lane) {
    int kr = 8 * wave + (lane >> 3); const int kc = (lane & 7) ^ ((kr >> 1) & 7); if (kr >= nvalid) kr = nvalid - 1;
    __builtin_amdgcn_global_load_lds((const unsigned*)(Kb + (row0 + kr) * 512 + h * 64 + kc * 8), (LAS unsigned*)(lds + AT_K + slot * AT_SLOT + wave * 1024), 16, 0, 0);
    int vr = 16 * (wave & 3) + (lane >> 2); if (vr >= nvalid) vr = nvalid - 1;
    __builtin_amdgcn_global_load_lds((const unsigned*)(Vb + (row0 + vr) * 512 + h * 64 + (wave >> 2) * 32 + (lane & 3) * 8), (LAS unsigned*)(lds + AT_V + slot * AT_SLOT + wave * 1024), 16, 0, 0);
}
__device__ __forceinline__ void stage_bias(Frame& F, const Args& A, int layer, int h) {
    const float* rb = A.in[F_IN_RB] + ((size_t)layer * NH + h) * NREL;
    int tid_ = F.tid; asm volatile("" : "+v"(tid_));
    if (tid_ < 255) { int d = tid_ - 63; if (d > 128) d = 128; ((LAS float*)(F.lds + AT_BT))[tid_] = LOG2E * (rb[d + 128] - rb[256]); }
}
__device__ __forceinline__ void attn_store(Frame& F, int lane_, const AttnState& st, bf16* O, size_t orow0, int h, int nrows) {
    const int r32 = lane_ & 31, hi = lane_ >> 5;
    const float lt = swapsum(st.l);
    LAS float* wsf = (LAS float*)(F.lds + AT_WS) + F.wave * 64;
    if (hi == 0) wsf[r32] = __builtin_amdgcn_rcpf(lt);
    LDS_WAIT(); asm volatile("" ::: "memory");
#pragma unroll
    for (int r = 0; r < 16; ++r) { const int q = crow(r, hi); const float a = wsf[q];
        if (q < nrows) {
#pragma unroll
            for (int d0 = 0; d0 < 2; ++d0) O[(orow0 + q) * DM + h * 64 + d0 * 32 + r32] = (bf16)(cvtpk(st.o[d0][r] * a, 0.f) & 0xffffu); } }
    LDS_WAIT(); asm volatile("" ::: "memory");
}
__device__ __forceinline__ void attn_prompt_unit(Frame& F, const Args& A, int layer, int b, int h, int c0) {
    const bf16* Q = (const bf16*)(F.ws + WS_ACT + A_Q); const bf16* Kb = (const bf16*)(F.ws + WS_ACT + A_K); const bf16* Vb = (const bf16*)(F.ws + WS_ACT + A_V);
    bf16* O = (bf16*)(F.ws + WS_ACT + A_OAB);
    int lane_ = F.lane; asm volatile("" : "+v"(lane_));
    const int r32 = lane_ & 31, hi = lane_ >> 5, ci = c0 + (F.wave >> 1), iq = 32 * (F.wave & 1) + r32;
    const size_t qrow = (size_t)b * SEQ + c0 * 64 + F.wave * 32;
    stage_bias(F, A, layer, h);
    const float cb = LOG2E * A.in[F_IN_RB][((size_t)layer * NH + h) * NREL + 256];
    bf16x8 qr[4];
#pragma unroll
    for (int d0 = 0; d0 < 4; ++d0) qr[d0] = *(const bf16x8*)(Q + (qrow + r32) * 512 + h * 64 + d0 * 16 + hi * 8);
    AttnState st; attn_init(st, cb);
    const int jlo = c0 >= 8 ? c0 - 8 : 0, nt = c0 + 4 - jlo;
#pragma unroll
    for (int i = 0; i < 3; ++i) if (i < nt) stage_kv_bf16(F.lds, i, Kb, Vb, (size_t)b * SEQ + (jlo + i) * 64, 64, h, F.wave, lane_);
    LDS_WAIT();
    for (int i = 0; i < nt; ++i) {
        const int rem = nt - 1 - i;
        if (rem >= 2) asm volatile("s_waitcnt vmcnt(4)" ::: "memory"); else if (rem == 1) asm volatile("s_waitcnt vmcnt(2)" ::: "memory"); else asm volatile("s_waitcnt vmcnt(0)" ::: "memory");
        __builtin_amdgcn_s_barrier(); asm volatile("" ::: "memory");
        if (i + 3 < nt) stage_kv_bf16(F.lds, (i + 3) & 3, Kb, Vb, (size_t)b * SEQ + (jlo + i + 3) * 64, 64, h, F.wave, lane_);
        const int dj = ci - (jlo + i);
        if (dj >= 0 && dj <= 8) attn_tile(F.lds, i & 3, qr, st, dj, iq, 64, F.wave, lane_);
    }
    attn_store(F, lane_, st, O, qrow, h, 32);
    __syncthreads();
}
__device__ __forceinline__ void attn_sample_unit(Frame& F, const Args& A, int layer, int sb, int h) {
    const bf16* Q = (const bf16*)(F.ws + WS_ACT + A_Q); const bf16* Kb = (const bf16*)(F.ws + WS_ACT + A_K); const bf16* Vb = (const bf16*)(F.ws + WS_ACT + A_V);
    bf16* O = (bf16*)(F.ws + WS_ACT + A_OAB);
    const float* ck = A.in[F_IN_CK] + ((size_t)(layer * DECB + sb) * 512) * 512 + h * 64;
    const float* cv = A.in[F_IN_CV] + ((size_t)(layer * DECB + sb) * 512) * 512 + h * 64;
    int lane_ = F.lane; asm volatile("" : "+v"(lane_));
    const int r32 = lane_ & 31, hi = lane_ >> 5, iq = r32 & 15;
    const size_t qrow = (size_t)MP + sb * 16;
    stage_bias(F, A, layer, h);
    const float cb = LOG2E * A.in[F_IN_RB][((size_t)layer * NH + h) * NREL + 256];
    bf16x8 qr[4];
#pragma unroll
    for (int d0 = 0; d0 < 4; ++d0) qr[d0] = *(const bf16x8*)(Q + (qrow + iq) * 512 + h * 64 + d0 * 16 + hi * 8);
    AttnState st; attn_init(st, cb);
    int tid_ = F.tid; asm volatile("" : "+v"(tid_));
    const int crw = tid_ >> 3, ccl = (tid_ & 7) * 8;
    const unsigned kdst = AT_K + crw * 128 + (((ccl >> 3) ^ ((crw >> 1) & 7)) << 4), vdst = AT_V + ((ccl >> 5) * 4 + (crw >> 4)) * 1024 + (crw & 15) * 64 + (ccl & 31) * 2;
    f32x4 ka[2], kb2[2], va[2], vb2[2];
#define CACHE_LOAD(S_, jt) do { const float* kp = ck + (size_t)((jt) * 64 + crw) * 512 + ccl; ka[S_] = *(const f32x4*)kp; kb2[S_] = *(const f32x4*)(kp + 4); \
                                const float* vp_ = cv + (size_t)((jt) * 64 + crw) * 512 + ccl; va[S_] = *(const f32x4*)vp_; vb2[S_] = *(const f32x4*)(vp_ + 4); } while (0)
#define CACHE_COMMIT(S_, slot) do { v4u w; w.x = cvtpk(ka[S_][0], ka[S_][1]); w.y = cvtpk(ka[S_][2], ka[S_][3]); w.z = cvtpk(kb2[S_][0], kb2[S_][1]); w.w = cvtpk(kb2[S_][2], kb2[S_][3]); \
                                *(LAS v4u*)(F.lds + (slot) * AT_SLOT + kdst) = w; \
                                w.x = cvtpk(va[S_][0], va[S_][1]); w.y = cvtpk(va[S_][2], va[S_][3]); w.z = cvtpk(vb2[S_][0], vb2[S_][1]); w.w = cvtpk(vb2[S_][2], vb2[S_][3]); \
                                *(LAS v4u*)(F.lds + (slot) * AT_SLOT + vdst) = w; } while (0)
    CACHE_LOAD(0, 0); CACHE_LOAD(1, 1);
    CACHE_COMMIT(0, 0); CACHE_LOAD(0, 2);
    LDS_WAIT(); __syncthreads();
#define SAMPLE_STEP(S_) do { const int jt = 2 * g2 + (S_), slot = jt & 1; \
        if (jt + 1 <= 7) CACHE_COMMIT(((S_) + 1) & 1, slot ^ 1); \
        if (jt + 3 <= 7) CACHE_LOAD(((S_) + 1) & 1, jt + 3); \
        if (jt == 7) stage_kv_bf16(F.lds, slot ^ 1, Kb, Vb, qrow, 16, h, F.wave, lane_); \
        if (F.wave == 0) attn_tile(F.lds, slot, qr, st, 8 - jt, iq, jt == 8 ? 16 : 64, F.wave, lane_);     \
        if (jt == 7) VM_WAIT(); \
        LDS_WAIT(); __syncthreads(); } while (0)
#pragma unroll 1
    for (int g2 = 0; g2 < 4; ++g2) { SAMPLE_STEP(0); SAMPLE_STEP(1); }
    { const int g2 = 4; SAMPLE_STEP(0); }
#undef SAMPLE_STEP
#undef CACHE_LOAD
#undef CACHE_COMMIT
    if (F.wave == 0) attn_store(F, lane_, st, O, qrow, h, 16);
    __syncthreads();
}

constexpr int SP_W = 0, SP_LD = 136, SP_V = 34816, SP_M = SP_V + 32768, SP_MLD = 68;
__device__ __forceinline__ void spatial_stage_w(Frame& F, const Args& A, int layer, int g) {
    const float* Wsp = A.in[F_IN_WSP] + ((size_t)layer * NG + g) * 128 * 128;
    LAS bf16* Wt = (LAS bf16*)(F.lds + SP_W);
    int tid_ = F.tid; asm volatile("" : "+v"(tid_));
    f32x4 wv[8];
#pragma unroll
    for (int j = 0; j < 8; ++j) { const int i = tid_ + j * (NWAVES * 64), t = i >> 5, s0 = (i & 31) * 4; wv[j] = *(const f32x4*)(Wsp + t * 128 + s0); }
    __builtin_amdgcn_sched_barrier(0);
#pragma unroll
    for (int j = 0; j < 8; ++j) { const int i = tid_ + j * (NWAVES * 64), t = i >> 5, s0 = (i & 31) * 4; const f32x4 w = wv[j];
        u32x2 o; o.x = cvtpk(s0 + 0 <= t ? w.x : 0.f, s0 + 1 <= t ? w.y : 0.f); o.y = cvtpk(s0 + 2 <= t ? w.z : 0.f, s0 + 3 <= t ? w.w : 0.f);
        *(LAS u32x2*)(Wt + t * SP_LD + s0) = o; }
}
__device__ __forceinline__ void spatial_unit(Frame& F, const Args& A, int layer, size_t row0, int g, int nvalid, float* bs_out  ) {
    const bf16* UB = (const bf16*)(F.ws + WS_ACT + A_UB); const bf16* VB = (const bf16*)(F.ws + WS_ACT + A_VB); const float* VSS = (const float*)(F.ws + WS_VSS);
    bf16* O = (bf16*)(F.ws + WS_ACT + A_OAB);
    const float* bsp = A.in[F_IN_BSP] + ((size_t)layer * NG + g) * 128;
    const float* vg = A.in[F_IN_VG] + (size_t)layer * DB + g * GD;
    int tid_ = F.tid; asm volatile("" : "+v"(tid_)); const int lane_ = tid_ & 63;
    {
        const int nrow = nvalid < 32 ? 32 : nvalid, nit = (nrow * 16 + NWAVES * 64 - 1) / (NWAVES * 64);
        v4u vv[4]; f32x4 sa[4], sb[4];
        const int d0 = (tid_ & 15) * 8;
        const f32x4 g0 = *(const f32x4*)(vg + d0), g1 = *(const f32x4*)(vg + d0 + 4);
#pragma unroll
        for (int it = 0; it < 4; ++it) { const int s = (tid_ >> 4) + it * 32;
            if (it < nit && s < nvalid) { const size_t row = row0 + s; vv[it] = *(const v4u*)(VB + row * 512 + g * GD + d0); sa[it] = *(const f32x4*)(VSS + row * 8); sb[it] = *(const f32x4*)(VSS + row * 8 + 4); }
            else { vv[it] = (v4u){0u, 0u, 0u, 0u}; sa[it] = (f32x4){1.f, 1.f, 1.f, 1.f}; sb[it] = sa[it]; } }
        __builtin_amdgcn_sched_barrier(0);
#pragma unroll
        for (int it = 0; it < 4; ++it) { const int s = (tid_ >> 4) + it * 32;
            if (it < nit) {
                v4u o = {0u, 0u, 0u, 0u};
                if (s < nvalid) {
                    const v4u v = vv[it];
                    const float rstd = __builtin_amdgcn_rsqf(((sa[it].x + sa[it].y) + (sa[it].z + sa[it].w) + (sb[it].x + sb[it].y) + (sb[it].z + sb[it].w)) * (1.0f / DB) + EPS);
                    float x[8];
                    x[0] = bflo(v.x) * rstd * g0.x; x[1] = bfhi(v.x) * rstd * g0.y; x[2] = bflo(v.y) * rstd * g0.z; x[3] = bfhi(v.y) * rstd * g0.w;
                    x[4] = bflo(v.z) * rstd * g1.x; x[5] = bfhi(v.z) * rstd * g1.y; x[6] = bflo(v.w) * rstd * g1.z; x[7] = bfhi(v.w) * rstd * g1.w;
                    if (bs_out) { float* p = bs_out + (size_t)s * 512 + g * GD + d0; *(f32x4*)p = (f32x4){x[0], x[1], x[2], x[3]}; *(f32x4*)(p + 4) = (f32x4){x[4], x[5], x[6], x[7]}; }
                    o.x = cvtpk(x[0], x[1]); o.y = cvtpk(x[2], x[3]); o.z = cvtpk(x[4], x[5]); o.w = cvtpk(x[6], x[7]);
                }
                *(LAS v4u*)(F.lds + SP_V + ((d0 >> 5) * 8 + (s >> 4)) * 1024 + (s & 15) * 64 + (d0 & 31) * 2) = o; } }
    }
    LDS_WAIT(); __syncthreads();
    const int r32 = lane_ & 31, hi = lane_ >> 5, tb = F.wave >> 1, db = F.wave & 1;
    if (tb * 32 < nvalid) {
        f32x16 acc[2]; acc[0] = f32x16{}; acc[1] = f32x16{};
        float btv[16];
#pragma unroll
        for (int r = 0; r < 16; ++r) btv[r] = bsp[32 * tb + crow(r, hi)];
        __builtin_amdgcn_sched_barrier(0);
        const LAS unsigned char* wp = F.lds + SP_W + ((32 * tb + r32) * SP_LD + 4 * hi) * 2;
        const LAS unsigned char* vp = F.lds + SP_V + ((lane_ >> 4) & 1) * 32 + (lane_ & 3) * 8 + (4 * hi + ((lane_ & 15) >> 2)) * 64 + (2 * db) * 8192;
        for (int kk = 0; kk < 2 * (tb + 1); ++kk) {
            const s16x4 a0 = *(const LAS s16x4*)(wp + kk * 32), a1 = *(const LAS s16x4*)(wp + kk * 32 + 16);
            const bf16x8 a = (bf16x8){a0[0], a0[1], a0[2], a0[3], a1[0], a1[1], a1[2], a1[3]};
#pragma unroll
            for (int dt = 0; dt < 2; ++dt) { const s16x4 lo = vtr(vp + dt * 8192 + kk * 1024), hh = vtr(vp + dt * 8192 + kk * 1024 + 512);
                const bf16x8 vf = (bf16x8){lo[0], lo[1], lo[2], lo[3], hh[0], hh[1], hh[2], hh[3]};
                acc[dt] = __builtin_amdgcn_mfma_f32_32x32x16_bf16(a, vf, acc[dt], 0, 0, 0); }
        }
        LAS float* M = (LAS float*)(F.lds + SP_M) + F.wave * 32 * SP_MLD;
#pragma unroll
        for (int r = 0; r < 16; ++r) { const int tl = crow(r, hi); const float bt = btv[r]; M[tl * SP_MLD + r32] = acc[0][r] + bt; M[tl * SP_MLD + 32 + r32] = acc[1][r] + bt; }
        LDS_WAIT(); asm volatile("" ::: "memory");
        v4u ubv[4];
#pragma unroll
        for (int it = 0; it < 4; ++it) { const int j = it * 64 + lane_, tl = j >> 3, d8 = (j & 7) * 8, t = 32 * tb + tl;
            ubv[it] = t < nvalid ? *(const v4u*)(UB + (row0 + t) * 512 + g * GD + 64 * db + d8) : (v4u){0u, 0u, 0u, 0u}; }
        __builtin_amdgcn_sched_barrier(0);
#pragma unroll
        for (int it = 0; it < 4; ++it) { const int j = it * 64 + lane_, tl = j >> 3, d8 = (j & 7) * 8, t = 32 * tb + tl;
            if (t < nvalid) {
                const f32x4 m0 = *(const LAS f32x4*)(M + tl * SP_MLD + d8), m1 = *(const LAS f32x4*)(M + tl * SP_MLD + d8 + 4);
                const v4u ub = ubv[it];
                v4u o; o.x = cvtpk(bflo(ub.x) * m0.x, bfhi(ub.x) * m0.y); o.y = cvtpk(bflo(ub.y) * m0.z, bfhi(ub.y) * m0.w); o.z = cvtpk(bflo(ub.z) * m1.x, bfhi(ub.z) * m1.y); o.w = cvtpk(bflo(ub.w) * m1.z, bfhi(ub.w) * m1.w);
                *(v4u*)(O + (row0 + t) * DM + 512 + g * GD + 64 * db + d8) = o; } }
    }
    LDS_WAIT(); __syncthreads();
}
#ifndef REP_MX
#define REP_MX 0
#endif
#define REPM(k) for (int reps_ = [] { int r = (REP_MX == (k)) ? 2 : 1; asm volatile("" : "+s"(r)); return r; }(), r_ = 0; r_ < reps_; ++r_)
__device__ __forceinline__ void mixer_phase(Frame& F, const Args& A, int layer) {
    const int x_ = F.vcu >> 5, j_ = F.vcu & 31, bh_ = 2 * x_ + (j_ & 1);
    const int grp = F.G == 256 ? (j_ >> 1) % 3 : 2;
#define MIX_P(k_) do { if (F.G == 256) attn_prompt_unit(F, A, layer, bh_ >> 3, bh_ & 7, (31 - ((j_ >> 1) + 16 * (k_))) * 4); } while (0)
#define MIX_M() do { \
    REPM(2) for (int u = F.vcu; u < DECB * NH; u += F.G) attn_sample_unit(F, A, layer, u >> 3, u & 7); \
    if (F.G % 4 == 0) { __syncthreads(); spatial_stage_w(F, A, layer, F.vcu & 3); } \
    REPM(3) for (int u = F.vcu; u < (MP / 128) * NG; u += F.G) spatial_unit(F, A, layer, (size_t)(u >> 2) * 128, u & 3, 128, nullptr); \
    REPM(4) for (int u = F.vcu; u < DECB * NG; u += F.G) spatial_unit(F, A, layer, (size_t)MP + (u >> 2) * 16, u & 3, 16, F.out + O_BS + (size_t)layer * DECB * DECT * 512 + (size_t)(u >> 2) * DECT * 512); \
    } while (0)
    if (F.G != 256) { for (int u = F.vcu; u < NBATCH * NH * 32; u += F.G) { const int cg = 31 - (u >> 4), bh = u & 15; attn_prompt_unit(F, A, layer, bh >> 3, bh & 7, cg * 4); } }
    if (grp == 0) MIX_M();
    MIX_P(0);
    if (grp == 1) MIX_M();
    MIX_P(1);
    if (grp == 2) MIX_M();
#undef MIX_P
#undef MIX_M
}
struct MiniOutAB {
    static constexpr bool MIDK = true, POST = false;
    const bf16 *GR, *GB; bf16* MIX;
    static constexpr bool LATE = true;
    __device__ __forceinline__ u32x2 gload(const bf16* G, int row, int col) const { return *(const u32x2*)(G + (size_t)row * DM + col); }
    __device__ __forceinline__ void mid(f32x4& acc, int row, int col) const { const u32x2 w = *(const u32x2*)(GR + (size_t)row * DM + col); acc = acc * (f32x4){bflo(w.x), bfhi(w.x), bflo(w.y), bfhi(w.y)}; }
    __device__ __forceinline__ float fin(const f32x4& acc, int row, int col) const { const u32x2 w = *(const u32x2*)(GB + (size_t)row * DM + col);
        const f32x4 v = acc * (f32x4){bflo(w.x), bfhi(w.x), bflo(w.y), bfhi(w.y)}; u32x2 o; o.x = cvtpk(v.x, v.y); o.y = cvtpk(v.z, v.w); *(u32x2*)(MIX + (size_t)row * DM + col) = o; return 0.f; }
};
struct MiniRes {
    static constexpr bool MIDK = false, POST = true, LATE = true;
    const float* xin_s; const bf16* xbf; const float* gsi; float* xout; const float* gate; const float* gs; bf16* XS; float* SS;
    __device__ __forceinline__ void mid(f32x4&, int, int) const {}
    __device__ __forceinline__ u32x2 xload(int row, int col) const { return xbf ? *(const u32x2*)(xbf + (size_t)row * DM + col) : (u32x2){0u, 0u}; }
    __device__ __forceinline__ float fin(const f32x4& acc, int row, int col) const { return fin_x(acc, xload(row, col), row, col); }
    __device__ __forceinline__ float fin_x(const f32x4& acc, const u32x2 w, int row, int col) const {
        const int bidx = NBATCH + ((row - MP) >> 4);
        const f32x4 g = *(const f32x4*)(gate + (size_t)bidx * 6144 + col);
        f32x4 x;
        if (xbf) { x = (f32x4){bflo(w.x), bfhi(w.x), bflo(w.y), bfhi(w.y)} * *(const f32x4*)(gsi + (size_t)bidx * DM + col); }
        else x = *(const f32x4*)(xin_s + (size_t)(row - MP) * DM + col);
        const f32x4 xn = x + g * acc;
        if (xout) *(f32x4*)(xout + (size_t)row * DM + col) = xn;
        if (gs) { const f32x4 y = xn * *(const f32x4*)(gs + (size_t)bidx * DM + col); u32x2 o; o.x = cvtpk(y.x, y.y); o.y = cvtpk(y.z, y.w); *(u32x2*)(XS + (size_t)row * DM + col) = o; }
        return (xn.x * xn.x + xn.y * xn.y) + (xn.z * xn.z + xn.w * xn.w); }
};
template <class Em> struct StripT {
    static constexpr bool ON = true, LATE = Em::LATE;
    const bf16* zA; Em em;
    __device__ __forceinline__ void mid(f32x4& accx, const pg8::Unit& u, int wr, int wc, int fr, int fq) const { asm volatile("" : "+v"(fr), "+v"(fq));
        em.mid(accx, MP + (u.pm >> 1) * 16 + fr, u.pn * 256 + (u.pm & 1) * 128 + wc * 32 + 8 * fq + 4 * wr); }
    __device__ __forceinline__ void fin(const f32x4& accx, const pg8::Unit& u, int wr, int wc, int fr, int fq, LAS unsigned char* red_, int wid) const {
        asm volatile("" : "+v"(fr), "+v"(fq));
        const int row0 = MP + (u.pm >> 1) * 16;
        float ss = em.fin(accx, row0 + fr, u.pn * 256 + (u.pm & 1) * 128 + wc * 32 + 8 * fq + 4 * wr);
        if constexpr (Em::POST) {
            ss += __builtin_bit_cast(float, __builtin_amdgcn_ds_swizzle(__builtin_bit_cast(int, ss), 0x401F)); ss = swapsum(ss);
            LAS float* red = (LAS float*)red_;
            if (fq == 0) red[fr * 8 + wid] = ss;
        } else { (void)ss; (void)red_; (void)wid; }
    }
    __device__ __forceinline__ u32x2 mid_load(const pg8::Unit& u, int wr, int wc, int fr, int fq) const { asm volatile("" : "+v"(fr), "+v"(fq));
        if constexpr (Em::MIDK) return em.gload(em.GR, MP + (u.pm >> 1) * 16 + fr, u.pn * 256 + (u.pm & 1) * 128 + wc * 32 + 8 * fq + 4 * wr); else return (u32x2){0u, 0u}; }
    __device__ __forceinline__ void mid_apply(f32x4& accx, const u32x2 w) const { accx = accx * (f32x4){bflo(w.x), bfhi(w.x), bflo(w.y), bfhi(w.y)}; }
    __device__ __forceinline__ u32x2 fin_load(const pg8::Unit& u, int wr, int wc, int fr, int fq) const { asm volatile("" : "+v"(fr), "+v"(fq));
        const int row = MP + (u.pm >> 1) * 16 + fr, col = u.pn * 256 + (u.pm & 1) * 128 + wc * 32 + 8 * fq + 4 * wr;
        if constexpr (Em::MIDK) return em.gload(em.GB, row, col); else return em.xload(row, col); }
    __device__ __forceinline__ void fin_apply(const f32x4& accx, const u32x2 w, const pg8::Unit& u, int wr, int wc, int fr, int fq, LAS unsigned char* red_, int wid) const { asm volatile("" : "+v"(fr), "+v"(fq));
        const int row = MP + (u.pm >> 1) * 16 + fr, col = u.pn * 256 + (u.pm & 1) * 128 + wc * 32 + 8 * fq + 4 * wr;
        if constexpr (Em::MIDK) { const f32x4 v = accx * (f32x4){bflo(w.x), bfhi(w.x), bflo(w.y), bfhi(w.y)}; u32x2 o; o.x = cvtpk(v.x, v.y); o.y = cvtpk(v.z, v.w); *(u32x2*)(em.MIX + (size_t)row * DM + col) = o; (void)red_; (void)wid; }
        else { float ss = em.fin_x(accx, w, row, col);
            ss += __builtin_bit_cast(float, __builtin_amdgcn_ds_swizzle(__builtin_bit_cast(int, ss), 0x401F)); ss = swapsum(ss);
            LAS float* red = (LAS float*)red_; if (fq == 0) red[fr * 8 + wid] = ss; } }
    __device__ __forceinline__ void post(const pg8::Unit& u, int fr, int fq, LAS unsigned char* red_, int wid) const {
        if constexpr (Em::POST) {
            asm volatile("" : "+v"(fr), "+v"(fq));
            const int row0 = MP + (u.pm >> 1) * 16;
            LAS float* red = (LAS float*)red_;
            LDS_WAIT(); __builtin_amdgcn_s_barrier(); asm volatile("" ::: "memory");
            const int l_ = fr;
            if (wid == 0 && fq == 0 && em.SS) { const LAS f32x4* r = (const LAS f32x4*)(red + l_ * 8); const f32x4 a = r[0], b = r[1]; const int slot = u.pn * 2 + (u.pm & 1);
                em.SS[(size_t)(row0 + l_) * 16 + slot] = ((a.x + a.y) + (a.z + a.w)) + ((b.x + b.y) + (b.z + b.w)); em.SS[(size_t)(row0 + l_) * 16 + slot + 8] = 0.f; }
        }
    }
};
constexpr int MG_BUF = 49152;
template <class Epi> __device__ __forceinline__ void mini_gemm(Frame& F, const bf16* Ab  , const bf16* Bt  , int K, const Epi& E) {
    int tid_ = F.tid; asm volatile("" : "+v"(tid_));
    const int lane_ = tid_ & 63, fr = lane_ & 15, fq = lane_ >> 4;
    const int rg = F.wave >> 2, cg = F.wave & 3, nb = K >> 8;
    for (int tile = F.vcu; tile < 256; tile += F.G) {
        const int rowb = MP + (tile >> 4) * 32, cb = tile & 15;
        const bf16* src[6];
#pragma unroll
        for (int j = 0; j < 6; ++j) { const int p = j * 512 + tid_, hr = p >> 4, c = p & 15, row = hr >> 1, h = hr & 1;
            const bf16* rp = row < 32 ? Ab + (size_t)(rowb + row) * K : Bt + (size_t)(cb * 64 + row - 32) * K;
            src[j] = rp + h * 128 + ((c ^ (row & 15)) * 8); }
#define MG_ISSUE(b_) do { _Pragma("unroll") for (int j = 0; j < 6; ++j) \
        __builtin_amdgcn_global_load_lds((const unsigned*)(src[j] + (size_t)(b_) * 256), (LAS unsigned*)(F.lds + ((b_) & 1) * MG_BUF + j * 8192 + F.wave * 1024), 16, 0, 0); } while (0)
        const int aoff = (rg * 16 + fr) * 512, boff = (32 + cg * 16 + fr) * 512;
        f32x4 acc = {0.f, 0.f, 0.f, 0.f};
        MG_ISSUE(0);
        for (int b = 0; b < nb; ++b) {
            if (b + 1 < nb) { MG_ISSUE(b + 1); asm volatile("s_waitcnt vmcnt(6)" ::: "memory"); } else asm volatile("s_waitcnt vmcnt(0)" ::: "memory");
            __builtin_amdgcn_s_barrier(); asm volatile("" ::: "memory");
            const LAS unsigned char* bufp = F.lds + (b & 1) * MG_BUF;
#pragma unroll
            for (int s = 0; s < 8; ++s) { const int so = (s >> 2) * 256 + ((((s & 3) * 4 + fq) ^ fr) * 16);
                const bf16x8 a = *(const LAS bf16x8*)(bufp + aoff + so), bw = *(const LAS bf16x8*)(bufp + boff + so);
                acc = __builtin_amdgcn_mfma_f32_16x16x32_bf16(bw, a, acc, 0, 0, 0); }
            if (Epi::MIDK) { if (b * 2 + 2 == nb) E.mid(acc, rowb + rg * 16 + fr, cb * 64 + cg * 16 + 4 * fq); }
            asm volatile("s_waitcnt lgkmcnt(0)" ::: "memory"); __builtin_amdgcn_s_barrier(); asm volatile("" ::: "memory");
        }
#undef MG_ISSUE
        float ss = E.fin(acc, rowb + rg * 16 + fr, cb * 64 + cg * 16 + 4 * fq);
        if constexpr (Epi::POST) {
            ss += __shfl_xor(ss, 16); ss += __shfl_xor(ss, 32);
            LAS float* red = (LAS float*)F.lds;
            __syncthreads();
            if (fq == 0) red[(rg * 16 + fr) * 4 + cg] = ss;
            __syncthreads();
            if (tid_ < 32 && E.SS) { const LAS float* r = red + tid_ * 4; E.SS[(size_t)(rowb + tid_) * 16 + cb] = (r[0] + r[1]) + (r[2] + r[3]); }
            LDS_WAIT(); __syncthreads();
        }
    }
}

#ifndef MK_PER_PHASE
#define MK_PER_PHASE 0
#endif
#ifndef STRIP_C
#define STRIP_C 1
#endif
#ifndef STRIP_D
#define STRIP_D 1
#endif
#ifndef STRIP_F
#define STRIP_F 1
#endif
#ifndef DMAF_A
#define DMAF_A false
#endif
#ifndef DMAF_E
#define DMAF_E false
#endif
#ifndef ASMDMA_A
#define ASMDMA_A false
#endif
#ifndef ASMDMA_E
#define ASMDMA_E true
#endif
#ifndef ASMDMA_C
#define ASMDMA_C true
#endif
#ifndef ASMDMA_D
#define ASMDMA_D true
#endif
#ifndef ASMDMA_F
#define ASMDMA_F true
#endif
constexpr int CV_TAIL_E = CV_I_IN + 2 * CV_I_OA + CV_I_O + CV_I_F1;
constexpr int N_PHASES = 2 + 6 * DEPTH;

__global__ void __launch_bounds__(NWAVES * 64, 2) fwd_kernel(Args args) {
    extern __shared__ __attribute__((aligned(16))) unsigned char lds[];
    Frame F;
    F.lds = (LAS unsigned char*)lds;
    F.MISC = (volatile LAS unsigned*)(F.lds + MISC_OFF);
    F.tid = threadIdx.x; F.lane = F.tid & 63; F.wave = __builtin_amdgcn_readfirstlane(F.tid >> 6);
    F.G = gridDim.x; { const int bx = blockIdx.x; F.vcu = (F.G % 8 == 0) ? (bx % 8) * (F.G / 8) + bx / 8 : bx; }
    F.ws = args.ws; F.out = args.out; F.ctl = (gu32*)(args.ws + WS_CTL);
    for (int u = F.tid; u < (LDS_BYTES - LDSCTL_OFF) / 4; u += NWAVES * 64) ((LAS unsigned*)(F.lds + LDSCTL_OFF))[u] = 0u;
    __syncthreads();
    XcdBarrier bar; bar.bar = (unsigned*)(F.ctl + CW_BAR); bar.x = 0; bar.st = nullptr;
    if (!MK_PER_PHASE) bar = xcd_barrier_post((unsigned*)(F.ctl + CW_BAR), F.MISC + 8);
    const int lo = args.ph_lo, hi = args.ph_hi;
#ifndef ONLY
#define ONLY -1
#endif
#define EN(t) (ONLY < 0 || ONLY == (t))
#ifndef REP_PH
#define REP_PH -1
#endif
#ifndef REP_N
#define REP_N 2
#endif
#define REPL(k) for (int reps_ = [] { int r = (REP_PH == (k)) ? REP_N : 1; asm volatile("" : "+s"(r)); return r; }(), r_ = 0; r_ < reps_; ++r_)
#define IN(k) (lo <= (k) && (k) < hi)
#define SEAM(k) do { if (IN(k) && IN((k) + 1)) xcd_barrier(bar); } while (0)

    if (EN(0) && IN(0)) REPL(0) { convert_items(F, args, 0, F.G == 256 ? CV_I_IN : DEPTH * CV_PER_L, F.vcu, F.G); p0_mod(F, args); } SEAM(0);
    if (EN(1) && IN(1)) REPL(1) { p1_pass(F, args); } SEAM(1);
    for (int l = 0; l < DEPTH; ++l) {
        const int pb = 2 + 6 * l;
        const float* GS = (const float*)(F.ws + WS_GS) + (size_t)l * 2 * NMODB * DM;
        unsigned char* wl = F.ws + WS_W + (size_t)l * W_LAYER;
        unsigned char* act = F.ws + WS_ACT;
        const float* MOD = (const float*)(F.ws + WS_MOD) + (size_t)l * NMODB * 6144;
        if (EN(2) && IN(pb + 0)) REPL(2) {
            pg8::Gemm g{(const bf16*)(F.ws + WS_H), (const bf16*)(wl + W_IN), MT, DIN, DM}; typedef pg8::SmpSwapOrderT<MT / 256, DIN / 256, MP / 256, 2> SO; SO S; { int bid_ = (int)blockIdx.x; asm volatile("" : "+s"(bid_)); S.init(F.G, bid_); }
            pg8::EpiIn E{act, (float*)(F.ws + WS_VSS), F.out, args.in[F_IN_QG] + l * HD, args.in[F_IN_KG] + l * HD, (const LAS float*)(F.lds + RTAB_OFF), (const LAS float*)(F.lds + EPIV_OFF), (const float*)(F.ws + WS_CV1) + (size_t)l * NMODB * DIN, l};
            auto pre = [&] { phase_prepass<false>(F, S, E.cv, DIN, nullptr, nullptr); };
            { pg8::Unit tu; constexpr int nfull = SO::nwg / 256, rem = SO::nwg - nfull * 256;
                if (F.G == 256 && !S.next(nfull, tu)) { convert_items(F, args, l * CV_PER_L + CV_I_IN, l * CV_PER_L + CV_TAIL_E, (int)blockIdx.x - rem, 256 - rem); __syncthreads(); } }
            pg8::gemm_phase<pg8::EpiIn, SO, true, true, pg8::NoStrip, decltype(pre), ASMDMA_A, DMAF_A>(F.lds, g, S, E, pg8::NoStrip(), pre);
#if REP_PH >= 0
            __syncthreads();
#endif
        }
        SEAM(pb + 0);
        if (EN(3) && IN(pb + 1)) REPL(3) { mixer_phase(F, args, l); }
        SEAM(pb + 1);
        if (EN(4) && IN(pb + 2)) REPL(4) {
            pg8::Gemm g{(const bf16*)(act + A_OAB), (const bf16*)(wl + W_AB), MP, DM, DM}; typedef pg8::StaticOrderT<MP / 256, DM / 256> SO; SO S; { int bid_ = (int)blockIdx.x; asm volatile("" : "+s"(bid_)); S.init(F.G, bid_); }
            pg8::EpiOutAB E{(const bf16*)(act + A_GR), (const bf16*)(act + A_GB), (bf16*)(act + A_MIX)};
            MiniOutAB Em{(const bf16*)(act + A_GR), (const bf16*)(act + A_GB), (bf16*)(act + A_MIX)};
            #if STRIP_C
            { const StripT<MiniOutAB> Z{(const bf16*)(act + A_OAB) + (size_t)MP * DM, Em}; pg8::gemm_phase<pg8::EpiOutAB, SO, true, true, StripT<MiniOutAB>, pg8::NoPre, ASMDMA_C>(F.lds, g, S, E, Z); }
#else
            { pg8::gemm_phase<pg8::EpiOutAB, SO, true, true>(F.lds, g, S, E); mini_gemm<MiniOutAB>(F, (const bf16*)(act + A_OAB), (const bf16*)(wl + W_AB), DM, Em); }
#endif
            ;
        }
        SEAM(pb + 2);
        if (EN(5) && IN(pb + 3)) for (int reps_ = [&] { int r = (REP_PH == 5 && l == 0) ? 2 : 1; asm volatile("" : "+s"(r)); return r; }(), r_ = 0; r_ < reps_; ++r_) {
            pg8::Gemm g{(const bf16*)(act + A_MIX), (const bf16*)(wl + W_O), MP, DM, DM}; typedef pg8::StaticOrderT<MP / 256, DM / 256> SO; SO S; { int bid_ = (int)blockIdx.x; asm volatile("" : "+s"(bid_)); S.init(F.G, bid_); }
            const float* GSI = (const float*)(F.ws + WS_GSI) + (size_t)l * 2 * NMODB * DM;

            MiniRes Em{nullptr, (const bf16*)(F.ws + WS_H), GSI, nullptr, MOD + 2 * DM, GS + NMODB * DM, (bf16*)(F.ws + WS_H), (float*)(F.ws + WS_SS)};
            { pg8::EpiRes<true> E{nullptr, (const bf16*)(F.ws + WS_H), GSI, nullptr, MOD + 2 * DM, GS + NMODB * DM, (bf16*)(F.ws + WS_H), (float*)(F.ws + WS_SS)};
              #if STRIP_D
            { const StripT<MiniRes> Z{(const bf16*)(act + A_MIX) + (size_t)MP * DM, Em}; pg8::gemm_phase<pg8::EpiRes<true>, SO, true, true, StripT<MiniRes>, pg8::NoPre, ASMDMA_D>(F.lds, g, S, E, Z); }
#else
            { pg8::gemm_phase<pg8::EpiRes<true>, SO, true, true>(F.lds, g, S, E); mini_gemm<MiniRes>(F, (const bf16*)(act + A_MIX), (const bf16*)(wl + W_O), DM, Em); }
#endif
            }
        }
        SEAM(pb + 3);
        if (EN(7) && IN(pb + 4)) REPL(7) {
            pg8::Gemm g{(const bf16*)(F.ws + WS_H), (const bf16*)(wl + W_F1), MT, 2 * DFF, DM}; typedef pg8::SmpSwapOrderT<MT / 256, 2 * DFF / 256, MP / 256, 2> SO; SO S; { int bid_ = (int)blockIdx.x; asm volatile("" : "+s"(bid_)); S.init(F.G, bid_); }
            pg8::EpiFfnIn E{(bf16*)(act + A_ACT), (float*)(act + A_SIDE), F.out, args.in[F_IN_CW] + (size_t)l * 3 * DFF, args.in[F_IN_CB] + (size_t)l * DFF, args.in[F_IN_CC] + (size_t)l * DECB * 2 * DFF,
                            (LAS float*)(F.lds + RING_BYTES), (const LAS float*)(F.lds + RTAB_OFF), (const LAS float*)(F.lds + EPIV_OFF), (const float*)(F.ws + WS_CV2) + (size_t)l * NMODB * 2 * DFF, l};
            auto pre = [&] { phase_prepass<true>(F, S, E.cv, 2 * DFF, E.cw, E.cb); };
            { pg8::Unit tu; constexpr int nfull = SO::nwg / 256, rem = SO::nwg - nfull * 256;
                if (F.G == 256 && !S.next(nfull, tu)) { convert_items(F, args, l * CV_PER_L + CV_TAIL_E, l + 1 < DEPTH ? (l + 1) * CV_PER_L + CV_I_IN : DEPTH * CV_PER_L, (int)blockIdx.x - rem, 256 - rem); __syncthreads();
                    if (l + 1 < DEPTH) { const int j_ = (int)blockIdx.x - rem; constexpr int n_ = 256 - rem, h_ = (n_ * 288) / 640;
                        if (j_ < h_) cvec_group(F, args, l + 1, 0, j_, h_); else cvec_group(F, args, l + 1, 1, j_ - h_, n_ - h_); } } }
            pg8::gemm_phase<pg8::EpiFfnIn, SO, true, true, pg8::NoStrip, decltype(pre), ASMDMA_E, DMAF_E>(F.lds, g, S, E, pg8::NoStrip(), pre);

#if REP_PH >= 0
            __syncthreads();
#endif
        }
        SEAM(pb + 4);
        if (EN(9) && IN(pb + 5)) {
            pg8::Gemm g{(const bf16*)(act + A_ACT), (const bf16*)(wl + W_F2), MP, DM, DFF}; typedef pg8::StaticOrderT<MP / 256, DM / 256> SO; SO S; { int bid_ = (int)blockIdx.x; asm volatile("" : "+s"(bid_)); S.init(F.G, bid_); }
            { pg8::Unit fu; for (int i = 0; S.next(i, fu); ++i) ffn_fixup(F, args, l, fu.pm); VM_WAIT(); __syncthreads(); }
            const float* gsn = l + 1 < DEPTH ? GS + 2 * NMODB * DM : nullptr;
            const float* GSI2 = (const float*)(F.ws + WS_GSI) + (size_t)l * 2 * NMODB * DM + NMODB * DM;
            pg8::EpiRes<true> E{nullptr, (const bf16*)(F.ws + WS_H), GSI2, gsn ? nullptr : F.out, MOD + 5 * DM, gsn, (bf16*)(F.ws + WS_H), (float*)(F.ws + WS_SS)};
            MiniRes Em{nullptr, (const bf16*)(F.ws + WS_H), GSI2, gsn ? nullptr : F.out, MOD + 5 * DM, gsn, (bf16*)(F.ws + WS_H), gsn ? (float*)(F.ws + WS_SS) : nullptr};
            #if STRIP_F
            { const StripT<MiniRes> Z{(const bf16*)(act + A_ACT) + (size_t)MP * DFF, Em}; pg8::gemm_phase<pg8::EpiRes<true>, SO, true, true, StripT<MiniRes>, pg8::NoPre, ASMDMA_F>(F.lds, g, S, E, Z); }
#else
            { pg8::gemm_phase<pg8::EpiRes<true>, SO, true, true>(F.lds, g, S, E); mini_gemm<MiniRes>(F, (const bf16*)(act + A_ACT), (const bf16*)(wl + W_F2), DFF, Em); }
#endif
            ;
        }
        SEAM(pb + 5);
    }
#undef IN
#undef SEAM
}

extern "C" void kernel_launch(void* const* d_in, const int* in_sizes, int n_in, void* d_out, int out_size, void* d_ws, size_t ws_size, hipStream_t stream) {
    static int grid = 0;
    if (grid == 0) {
        if (n_in != 25 || in_sizes[0] != MP * DM || out_size != (int)O_END || ws_size < WS_END) {
            fprintf(stderr, "kernel_launch: unexpected problem: n_in %d in0 %d out %d ws %zu (need %zu); nothing launched\n", n_in, n_in > 0 ? in_sizes[0] : -1, out_size, ws_size, (size_t)WS_END); grid = -1; return; }
        int dev = 0, cus = 0, per_cu = 0;
        if (hipGetDevice(&dev) != hipSuccess || hipDeviceGetAttribute(&cus, hipDeviceAttributeMultiprocessorCount, dev) != hipSuccess) { fprintf(stderr, "kernel_launch: device query failed\n"); grid = -1; return; }
        if (hipFuncSetAttribute((const void*)fwd_kernel, hipFuncAttributeMaxDynamicSharedMemorySize, LDS_BYTES) != hipSuccess) { fprintf(stderr, "kernel_launch: hipFuncSetAttribute failed\n"); grid = -1; return; }
        if (hipOccupancyMaxActiveBlocksPerMultiprocessor(&per_cu, (const void*)fwd_kernel, NWAVES * 64, LDS_BYTES) != hipSuccess || per_cu < 1) {
            fprintf(stderr, "kernel_launch: occupancy query reports %d workgroups per CU\n", per_cu); per_cu = 1; }
        (void)hipGetLastError();
        grid = cus;
    }
    if (grid < 0) return;
    if (hipMemsetAsync((char*)d_ws + WS_CTL, 0, CTL_ZERO_BYTES, stream) != hipSuccess) { fprintf(stderr, "kernel_launch: memset failed\n"); return; }
    Args a{};
    for (int i = 0; i < 25; ++i) a.in[i] = (const float*)d_in[i];
    a.out = (float*)d_out; a.ws = (unsigned char*)d_ws;
#if MK_PER_PHASE
    for (int ph = 0; ph < N_PHASES; ++ph) { a.ph_lo = ph; a.ph_hi = ph + 1; hipLaunchKernelGGL(fwd_kernel, dim3(grid), dim3(NWAVES * 64), LDS_BYTES, stream, a); }
#else
    a.ph_lo = 0; a.ph_hi = N_PHASES;
    hipLaunchKernelGGL(fwd_kernel, dim3(grid), dim3(NWAVES * 64), LDS_BYTES, stream, a);
#endif
    const hipError_t le = hipPeekAtLastError();
    if (le != hipSuccess) fprintf(stderr, "kernel_launch: launch failed: %s\n", hipGetErrorName(le));
}
```
